# Optimizing an MI355X kernel written in HIP

```python
import math
import jax, jax.numpy as jnp
from jax import lax
import numpy as np

D_MODEL = 1024
BATCH = 8
SEQ = 2048
DEPTH = 1

MIX_WIDTH = D_MODEL
GDN_WIDTH = MIX_WIDTH // 2
GDN_HEAD_DIM = 64
GDN_HEADS = GDN_WIDTH // GDN_HEAD_DIM
GDN_CHUNK = 64
CONV_K = 5
SGU_WIDTH = MIX_WIDTH - GDN_WIDTH
SGU_GROUPS = 4
SGU_GROUP_DIM = SGU_WIDTH // SGU_GROUPS
SGU_CHUNK = 128
FF_DIM = 4 * D_MODEL
EPS = 1e-6

SPLIT_SIZES = (GDN_WIDTH, GDN_WIDTH, GDN_WIDTH, GDN_WIDTH,
               GDN_HEADS, GDN_HEADS, GDN_HEADS, GDN_HEADS,
               SGU_WIDTH, SGU_WIDTH)
SPLIT_POINTS = tuple(int(s) for s in np.cumsum(SPLIT_SIZES)[:-1])
IN_COLS = sum(SPLIT_SIZES)

kernel_name = "hybrid_gdn_sgu_encoder_block"


def rms_norm(x, gain):
    xf = x.astype(jnp.float32)
    y = xf * lax.rsqrt(jnp.mean(xf * xf, axis=-1, keepdims=True) + EPS)
    return (y * gain.astype(jnp.float32)).astype(x.dtype)


def l2_normalize(x):
    return x * lax.rsqrt(jnp.sum(x * x, axis=-1, keepdims=True) + EPS)


def short_conv(x, w):
    c = x.shape[-1]
    return lax.conv_general_dilated(
        x, w[:, None, :].astype(x.dtype), window_strides=(1,),
        padding=[(CONV_K // 2, CONV_K // 2)],
        dimension_numbers=("NWC", "WIO", "NWC"), feature_group_count=c)


def gated_delta_rule_chunked(q, k, v, g, beta):
    bsz, nh, s, dk = q.shape
    dv = v.shape[-1]
    n = s // GDN_CHUNK
    q = q * (dk ** -0.5)

    def chunks(t):
        return t.reshape(bsz, nh, n, GDN_CHUNK, *t.shape[3:])

    q, k, v, g, beta = chunks(q), chunks(k), chunks(v), chunks(g), chunks(beta)
    g = jnp.cumsum(g, axis=-1)
    tri_incl = jnp.tril(jnp.ones((GDN_CHUNK, GDN_CHUNK), dtype=bool))
    tri_strict = jnp.tril(jnp.ones((GDN_CHUNK, GDN_CHUNK), dtype=bool), -1)
    diff = g[..., :, None] - g[..., None, :]
    decay = jnp.exp(jnp.where(tri_incl, diff, -jnp.inf))

    k_beta = k * beta[..., None]
    v_beta = v * beta[..., None]
    lower = jnp.where(tri_strict, jnp.einsum("bhnid,bhnjd->bhnij", k_beta, k) * decay, 0.0)
    a_mat = jnp.eye(GDN_CHUNK, dtype=jnp.float32) + lower
    rhs = jnp.concatenate([v_beta, k_beta * jnp.exp(g)[..., None]], axis=-1)
    sol = lax.linalg.triangular_solve(a_mat, rhs, left_side=True, lower=True, unit_diagonal=True)
    u_c, w_c = sol[..., :dv], sol[..., dv:]

    attn_intra = jnp.einsum("bhnid,bhnjd->bhnij", q, k) * decay
    q_dec = q * jnp.exp(g)[..., None]
    k_dec = k * jnp.exp(g[..., -1:] - g)[..., None]
    g_last = jnp.exp(g[..., -1])

    def step(state, inp):
        u_i, w_i, q_i, k_i, a_i, gl = inp
        v_new = u_i - jnp.einsum("bhid,bhde->bhie", w_i, state)
        o_i = jnp.einsum("bhid,bhde->bhie", q_i, state) + jnp.einsum("bhij,bhje->bhie", a_i, v_new)
        state = state * gl[..., None, None] + jnp.einsum("bhid,bhie->bhde", k_i, v_new)
        return state, o_i

    xs = tuple(jnp.moveaxis(t, 2, 0) for t in (u_c, w_c, q_dec, k_dec, attn_intra, g_last))
    state0 = jnp.zeros((bsz, nh, dk, dv), jnp.float32)
    _, o = lax.scan(step, state0, xs)
    return jnp.moveaxis(o, 0, 2).reshape(bsz, nh, s, dv)


def bidir_gated_deltanet(qkv, z, b_f, b_b, a_f, a_b, a_log_f, dt_bias_f, a_log_b, dt_bias_b, norm_gain):
    bsz, s, _ = qkv.shape
    q, k, v = jnp.split(qkv.astype(jnp.float32), 3, axis=-1)

    def heads(t):
        return t.reshape(bsz, s, GDN_HEADS, GDN_HEAD_DIM).transpose(0, 2, 1, 3)

    q, k, v = l2_normalize(heads(q)), l2_normalize(heads(k)), heads(v)

    def gates(b, a, a_log, dt_bias):
        beta = jax.nn.sigmoid(b.astype(jnp.float32)).transpose(0, 2, 1)
        g = -jnp.exp(a_log.astype(jnp.float32)) * jax.nn.softplus(
            a.astype(jnp.float32) + dt_bias.astype(jnp.float32))
        return g.transpose(0, 2, 1), beta

    g_f, beta_f = gates(b_f, a_f, a_log_f, dt_bias_f)
    g_b, beta_b = gates(b_b, a_b, a_log_b, dt_bias_b)
    o_fwd = gated_delta_rule_chunked(q, k, v, g_f, beta_f)
    flip = lambda t: jnp.flip(t, axis=2)
    o_bwd = flip(gated_delta_rule_chunked(flip(q), flip(k), flip(v), flip(g_b), flip(beta_b)))
    o = (o_fwd + o_bwd).transpose(0, 2, 1, 3)
    zf = z.astype(jnp.float32).reshape(bsz, s, GDN_HEADS, GDN_HEAD_DIM)
    o = rms_norm(o, norm_gain) * jax.nn.silu(zf)
    return o.reshape(bsz, s, GDN_WIDTH).astype(z.dtype)


def spatial_gating(u, v, v_gain, w_s, b_s, out_gain):
    bsz, s, _ = u.shape
    u = jax.nn.gelu(u, approximate=False).reshape(bsz, s, SGU_GROUPS, SGU_GROUP_DIM)
    v = jax.nn.gelu(v, approximate=False).reshape(bsz, s, SGU_GROUPS, SGU_GROUP_DIM)
    v = rms_norm(v, v_gain).reshape(bsz, s // SGU_CHUNK, SGU_CHUNK, SGU_GROUPS, SGU_GROUP_DIM)
    mixed = jnp.einsum("gts,bnsgc->bntgc", w_s, v) + b_s.T[:, :, None]
    gated = u * mixed.reshape(bsz, s, SGU_GROUPS, SGU_GROUP_DIM)
    return rms_norm(gated, out_gain).reshape(bsz, s, SGU_WIDTH)


def setup_inputs(seed: int = 0) -> dict:
    key = jax.random.key(seed)
    ks = jax.random.split(key, 20)
    f32 = jnp.float32
    L = DEPTH
    x = jax.random.normal(ks[0], (BATCH, SEQ, D_MODEL), f32)
    norm_mix = 1.0 + 0.02 * jax.random.normal(ks[1], (L, D_MODEL), f32)
    w_in = jax.random.normal(ks[2], (L, D_MODEL, IN_COLS), f32) * D_MODEL ** -0.5
    conv_w = jax.random.normal(ks[3], (L, CONV_K, 3 * GDN_WIDTH), f32) * CONV_K ** -0.5

    def decay_params(k_a, k_dt):
        a_log = jnp.log(jax.random.uniform(k_a, (L, GDN_HEADS), f32, 1.0, 16.0))
        dt = jnp.exp(jax.random.uniform(k_dt, (L, GDN_HEADS), f32, math.log(1e-3), math.log(1e-1)))
        dt_bias = dt + jnp.log(-jnp.expm1(-dt))
        return a_log, dt_bias

    a_log_fwd, dt_bias_fwd = decay_params(ks[4], ks[5])
    a_log_bwd, dt_bias_bwd = decay_params(ks[6], ks[7])
    gdn_norm = 1.0 + 0.02 * jax.random.normal(ks[8], (L, GDN_HEAD_DIM), f32)
    sgu_v_norm = 1.0 + 0.02 * jax.random.normal(ks[9], (L, SGU_GROUPS, SGU_GROUP_DIM), f32)
    sgu_w = jax.random.normal(ks[10], (L, SGU_GROUPS, SGU_CHUNK, SGU_CHUNK), f32) * SGU_CHUNK ** -0.5
    sgu_b = 1.0 + 0.02 * jax.random.normal(ks[11], (L, SGU_GROUPS, SGU_CHUNK), f32)
    sgu_out_norm = 1.0 + 0.02 * jax.random.normal(ks[12], (L, SGU_GROUPS, SGU_GROUP_DIM), f32)
    w_out = jax.random.normal(ks[13], (L, MIX_WIDTH, D_MODEL), f32) * MIX_WIDTH ** -0.5
    norm_ffn = 1.0 + 0.02 * jax.random.normal(ks[14], (L, D_MODEL), f32)
    w_ff1 = jax.random.normal(ks[15], (L, D_MODEL, FF_DIM), f32) * D_MODEL ** -0.5
    w_ff2 = jax.random.normal(ks[16], (L, FF_DIM, D_MODEL), f32) * FF_DIM ** -0.5
    norm_final = 1.0 + 0.02 * jax.random.normal(ks[17], (D_MODEL,), f32)
    return {"x": x, "norm_mix": norm_mix, "w_in": w_in, "conv_w": conv_w,
            "a_log_fwd": a_log_fwd, "dt_bias_fwd": dt_bias_fwd,
            "a_log_bwd": a_log_bwd, "dt_bias_bwd": dt_bias_bwd,
            "gdn_norm": gdn_norm, "sgu_v_norm": sgu_v_norm, "sgu_w": sgu_w, "sgu_b": sgu_b,
            "sgu_out_norm": sgu_out_norm, "w_out": w_out, "norm_ffn": norm_ffn,
            "w_ff1": w_ff1, "w_ff2": w_ff2, "norm_final": norm_final}


def reference(x, norm_mix, w_in, conv_w, a_log_fwd, dt_bias_fwd, a_log_bwd, dt_bias_bwd,
              gdn_norm, sgu_v_norm, sgu_w, sgu_b, sgu_out_norm, w_out, norm_ffn,
              w_ff1, w_ff2, norm_final):
    for l in range(DEPTH):
        h = rms_norm(x, norm_mix[l])
        proj = jnp.einsum("bsd,dc->bsc", h, w_in[l])
        q, k, v, z, b_f, b_b, a_f, a_b, su, sv = jnp.split(proj, SPLIT_POINTS, axis=-1)
        qkv = jax.nn.silu(short_conv(jnp.concatenate([q, k, v], axis=-1), conv_w[l]))
        o_a = bidir_gated_deltanet(qkv, z, b_f, b_b, a_f, a_b, a_log_fwd[l], dt_bias_fwd[l],
                                   a_log_bwd[l], dt_bias_bwd[l], gdn_norm[l])
        o_b = spatial_gating(su, sv, sgu_v_norm[l], sgu_w[l], sgu_b[l], sgu_out_norm[l])
        mix = jnp.concatenate([o_a, o_b], axis=-1)
        x = x + jnp.einsum("bsc,cd->bsd", mix, w_out[l])
        h = rms_norm(x, norm_ffn[l])
        ff = jnp.square(jax.nn.relu(jnp.einsum("bsd,df->bsf", h, w_ff1[l])))
        x = x + jnp.einsum("bsf,fd->bsd", ff, w_ff2[l])
    return rms_norm(x, norm_final)
```

```cpp
#include <hip/hip_runtime.h>
#include <hip/hip_cooperative_groups.h>
#include <cstdio>
#include <cstdint>
namespace cg = cooperative_groups;
namespace pg8 {
#define PG8_LAS __attribute__((address_space(3)))
typedef unsigned short bf16_t;
typedef short bf16x8 __attribute__((ext_vector_type(8)));
typedef float f32x4 __attribute__((ext_vector_type(4)));
typedef unsigned u32x4 __attribute__((ext_vector_type(4)));
constexpr int BM = 256, BK = 64, HALF = 128, HTB = HALF * BK * 2  , STAGE_BYTES = 8 * HTB, NXCD = 8, WGM = 8;

__host__ __device__ __forceinline__ int lds_byte(int r, int c) { const int st = (r >> 4) * 2 + (c >> 5), rr = r & 15, cc = c & 31, ob = rr * 64 + cc * 2; return st * 1024 + (ob ^ (((ob >> 9) & 1) << 5)); }
__host__ __device__ __forceinline__ void stage_rc(int b, int& R, int& C) { const int st = b / 1024, sb = b % 1024, swz = sb ^ (((sb >> 9) & 1) << 5); R = (st >> 1) * 16 + swz / 64; C = (st & 1) * 32 + (swz % 64) / 2; }
__host__ __device__ __forceinline__ int perm32(int rho) { const int n = rho >> 4, i = rho & 15; return 8 * (i >> 2) + 4 * n + (i & 3); }

struct Unit { int pm, pn; };
struct Gemm { const bf16_t* A; const bf16_t* Bt; int M, N, K; };

struct StaticOrder {
    int nM, nN, nwg, G, c;
    __host__ __device__ void init(int M, int N, int G_, int c_) { nM = M / BM; nN = N / BM; nwg = nM * nN; G = G_; c = c_; }
    __host__ __device__ bool next(int i, Unit& u) const {
        const long L = (long)i * G + c; if (L >= nwg) return false;
        int wgid = (int)L; { const int q = nwg / NXCD, r = nwg % NXCD, xcd = wgid % NXCD, off = wgid / NXCD; wgid = (xcd < r ? xcd * (q + 1) : r * (q + 1) + (xcd - r) * q) + off; }
        const int nig = WGM * nN, gid = wgid / nig, fm = gid * WGM, gsz = (nM - fm) < WGM ? (nM - fm) : WGM;
        u.pm = fm + ((wgid % nig) % gsz); u.pn = (wgid % nig) / gsz; return true;
    }
    __device__ __forceinline__ void a_ready(const Unit&) const {}
    __device__ __forceinline__ void done(const Unit&) const {}
};

typedef float f32x2c_t __attribute__((ext_vector_type(2))); typedef __bf16 bf16x2c_t __attribute__((ext_vector_type(2)));
__device__ __forceinline__ unsigned cvt_pk_bf16(float lo, float hi) { f32x2c_t v = {lo, hi}; bf16x2c_t b = __builtin_convertvector(v, bf16x2c_t); return __builtin_bit_cast(unsigned, b); }
typedef float f32x2 __attribute__((ext_vector_type(2)));
__device__ __forceinline__ f32x2 gelu_pk(f32x2 v) {
    const f32x2 av = __builtin_elementwise_abs(v), d = av * 0.2316418882f + 1.0f;
    f32x2 t; t.x = __builtin_amdgcn_rcpf(d.x); t.y = __builtin_amdgcn_rcpf(d.y);
    f32x2 q = t * 0.5307027145f + (-0.7265760135f); q = q * t + 0.7107068705f; q = q * t + (-0.142248368f); q = q * t + 0.127414796f; q = q * t;
    const f32x2 s = (v * v) * (-0.72134752044f);
    f32x2 e; e.x = __builtin_amdgcn_exp2f(s.x); e.y = __builtin_amdgcn_exp2f(s.y);
    const f32x2 m = v * (q * e), r = v - m;
    f32x2 o; o.x = v.x < 0.f ? m.x : r.x; o.y = v.y < 0.f ? m.y : r.y; return o;
}
template <int ACT  > struct EpiBf16 {
    static constexpr bool PERM = true, AFTER_DRAIN = false;
    bf16_t* O; int ldc; int split_cols; size_t split_stride;
    __device__ __forceinline__ void operator()(const f32x4 (&acc)[2][2][4][2], const Unit& u, int wr, int wc, int fr, int fq) const {
        const int row0 = u.pm * BM + wr * 64 + fr; int colt = u.pn * BM; bf16_t* base = O;
        if (split_cols) { const int t = colt / split_cols; base += (size_t)t * split_stride; colt -= t * split_cols; }
        const int col0 = colt + wc * 32 + 8 * fq;
#pragma unroll
        for (int ai = 0; ai < 2; ++ai)
#pragma unroll
            for (int m = 0; m < 4; ++m) { bf16_t* rowp = base + (size_t)(row0 + ai * HALF + m * 16) * ldc + col0;
#pragma unroll
                for (int bj = 0; bj < 2; ++bj) { f32x4 v0 = acc[ai][bj][m][0], v1 = acc[ai][bj][m][1];
                    if (ACT == 2) {
#pragma unroll
                        for (int e = 0; e < 4; ++e) { float a = fmaxf(v0[e], 0.f), b = fmaxf(v1[e], 0.f); v0[e] = a * a; v1[e] = b * b; } }
                    u32x4 w; w.x = cvt_pk_bf16(v0[0], v0[1]); w.y = cvt_pk_bf16(v0[2], v0[3]); w.z = cvt_pk_bf16(v1[0], v1[1]); w.w = cvt_pk_bf16(v1[2], v1[3]);
                    *(u32x4*)(rowp + bj * HALF) = w; } }
    }
};
struct EpiResF32 {
    static constexpr bool PERM = false, AFTER_DRAIN = false;
    const float* base; float* out; int ldc;
    __device__ __forceinline__ void operator()(const f32x4 (&acc)[2][2][4][2], const Unit& u, int wr, int wc, int fr, int fq) const {
        const int col0 = u.pn * BM + wc * 32 + 4 * fq;
#pragma unroll
        for (int ai = 0; ai < 2; ++ai)
#pragma unroll
            for (int m = 0; m < 4; ++m) { const size_t off = (size_t)(u.pm * BM + ai * HALF + wr * 64 + m * 16 + fr) * ldc + col0;
#pragma unroll
                for (int bj = 0; bj < 2; ++bj)
#pragma unroll
                    for (int n = 0; n < 2; ++n) { const f32x4 bs = *(const f32x4*)(base + off + bj * HALF + n * 16); *(f32x4*)(out + off + bj * HALF + n * 16) = bs + acc[ai][bj][m][n]; } }
    }
};
template <class Epi, class Sched, bool ALIGN_EPI = false, bool SP2 = false>
__device__ __forceinline__ void gemm_phase(PG8_LAS unsigned char* lds, const Gemm g, const Sched& S, const Epi& E) {
    const int tid = threadIdx.x, wid = __builtin_amdgcn_readfirstlane(tid >> 6), lane = tid & 63, wr = wid >> 2, wc = wid & 3, fr = lane & 15, fq = lane >> 4;
    const int K = g.K, nt = K / BK;
    unsigned voffA[2], voffB[2];
#pragma unroll
    for (int i = 0; i < 2; ++i) { int R, C; stage_rc(tid * 16 + i * 8192, R, C); const int Rb = Epi::PERM ? ((R & ~31) + perm32(R & 31)) : R;
        voffA[i] = (unsigned)(R * K + C) * 2u; voffB[i] = (unsigned)(Rb * K + C) * 2u; }
    const size_t kstep = (size_t)(BK * 2);
    const size_t hstep = (size_t)HALF * K * 2;
    const size_t tstep = 2 * hstep;
    const unsigned ldsw = (unsigned)wid * 1024u;
    const int aoff = lds_byte(wr * 64 + fr, fq * 8), boff = lds_byte(wc * 32 + fr, fq * 8);
#define PG8_SA(b, h) (((b) * 2 + (h)) * HTB)
#define PG8_SB(b, h) ((4 + (b) * 2 + (h)) * HTB)
#define PG8_STAGE(bufoff, gbase, voff) do { _Pragma("unroll") for (int _i = 0; _i < 2; ++_i) \
        __builtin_amdgcn_global_load_lds((const unsigned*)((const char*)(gbase) + (voff)[_i]), (PG8_LAS unsigned*)(lds + (bufoff) + ldsw + _i * 8192), 16, 0, 0); } while (0)
#define PG8_LDA(dst, b, h) do { _Pragma("unroll") for (int m = 0; m < 4; ++m) _Pragma("unroll") for (int k = 0; k < 2; ++k) dst[m][k] = *(const PG8_LAS bf16x8*)(lds + PG8_SA(b, h) + aoff + m * 2048 + k * 1024); } while (0)
#define PG8_LDB(dst, b, h) do { _Pragma("unroll") for (int n = 0; n < 2; ++n) _Pragma("unroll") for (int k = 0; k < 2; ++k) dst[n][k] = *(const PG8_LAS bf16x8*)(lds + PG8_SB(b, h) + boff + n * 2048 + k * 1024); } while (0)
#define PG8_MMA(ai, bj, At, Bt) do { __builtin_amdgcn_s_setprio(1); _Pragma("unroll") for (int m = 0; m < 4; ++m) _Pragma("unroll") for (int n = 0; n < 2; ++n) _Pragma("unroll") for (int k = 0; k < 2; ++k) \
        acc[ai][bj][m][n] = __builtin_amdgcn_mfma_f32_16x16x32_bf16(Bt[n][k], At[m][k], acc[ai][bj][m][n], 0, 0, 0); __builtin_amdgcn_s_setprio(0); } while (0)
#define PG8_WAIT_V(n) asm volatile("s_waitcnt vmcnt(" #n ")" ::: "memory")
#define PG8_WAIT_L(n) asm volatile("s_waitcnt lgkmcnt(" #n ")" ::: "memory")
#define PG8_BAR __builtin_amdgcn_s_barrier()
#define PG8_SCHED __builtin_amdgcn_sched_barrier(0)
    Unit cur, nxt; int ui = 0;
    if (!S.next(0, cur)) return;
    f32x4 acc[2][2][4][2];
#pragma unroll
    for (int a = 0; a < 2; ++a)
#pragma unroll
        for (int b = 0; b < 2; ++b)
#pragma unroll
            for (int m = 0; m < 4; ++m)
#pragma unroll
                for (int n = 0; n < 2; ++n) acc[a][b][m][n] = (f32x4){0.f, 0.f, 0.f, 0.f};
    bf16x8 At[4][2], B0[2][2], B1[2][2];
    const char* cA = (const char*)g.A + (size_t)cur.pm * tstep; const char* cB = (const char*)g.Bt + (size_t)cur.pn * tstep;
    S.a_ready(cur);
    if constexpr (SP2) {
        PG8_STAGE(PG8_SB(0, 0), cB, voffB); PG8_STAGE(PG8_SB(0, 1), cB + hstep, voffB); PG8_STAGE(PG8_SA(0, 0), cA, voffA); PG8_STAGE(PG8_SA(0, 1), cA + hstep, voffA);
        if (wr == 1) PG8_BAR;
        PG8_WAIT_V(2); PG8_BAR;
        PG8_STAGE(PG8_SB(1, 0), cB + kstep, voffB); PG8_STAGE(PG8_SA(1, 0), cA + kstep, voffA); PG8_STAGE(PG8_SB(1, 1), cB + hstep + kstep, voffB);
        PG8_WAIT_V(6); PG8_BAR;
    } else {
        PG8_STAGE(PG8_SB(0, 0), cB, voffB); PG8_STAGE(PG8_SA(0, 0), cA, voffA); PG8_STAGE(PG8_SB(0, 1), cB + hstep, voffB); PG8_STAGE(PG8_SA(0, 1), cA + hstep, voffA);
        if (wr == 1) PG8_BAR;
        PG8_WAIT_V(4); PG8_BAR;
        PG8_STAGE(PG8_SB(1, 0), cB + kstep, voffB); PG8_STAGE(PG8_SA(1, 0), cA + kstep, voffA); PG8_STAGE(PG8_SB(1, 1), cB + hstep + kstep, voffB);
        PG8_WAIT_V(6); PG8_BAR;
    }
    for (;;) {
        const bool has_next = S.next(ui + 1, nxt);
        const char* nA = has_next ? (const char*)g.A + (size_t)nxt.pm * tstep : cA; const char* nB = has_next ? (const char*)g.Bt + (size_t)nxt.pn * tstep : cB;
        for (int t = 0; t < nt; t += 2) {
            const bool last = (t == nt - 2);
            const char* a1 = cA + (size_t)(t + 1) * kstep;
            const char* a2 = last ? nA : cA + (size_t)(t + 2) * kstep; const char* b2 = last ? nB : cB + (size_t)(t + 2) * kstep;
            const char* a3 = a2 + kstep; const char* b3 = b2 + kstep;
            if (last && has_next) S.a_ready(nxt);
            if constexpr (SP2) {
            PG8_LDB(B0, 0, 0); PG8_LDB(B1, 0, 1); PG8_SCHED; PG8_LDA(At, 0, 0); PG8_STAGE(PG8_SA(1, 1), a1 + hstep, voffA);
            PG8_WAIT_V(8); PG8_WAIT_L(0); PG8_BAR; PG8_MMA(0, 0, At, B0); PG8_MMA(0, 1, At, B1); PG8_BAR; PG8_SCHED;
            PG8_LDA(At, 0, 1); PG8_STAGE(PG8_SB(0, 0), b2, voffB); PG8_STAGE(PG8_SB(0, 1), b2 + hstep, voffB); PG8_STAGE(PG8_SA(0, 0), a2, voffA);
            PG8_WAIT_V(8); PG8_WAIT_L(0); PG8_BAR; PG8_MMA(1, 0, At, B0); PG8_MMA(1, 1, At, B1); PG8_BAR; PG8_SCHED;
            PG8_LDB(B0, 1, 0); PG8_LDB(B1, 1, 1); PG8_SCHED; PG8_LDA(At, 1, 0); PG8_STAGE(PG8_SA(0, 1), a2 + hstep, voffA);
            PG8_WAIT_V(8); PG8_WAIT_L(0); PG8_BAR; PG8_MMA(0, 0, At, B0); PG8_MMA(0, 1, At, B1); PG8_BAR; PG8_SCHED;
            PG8_LDA(At, 1, 1); PG8_STAGE(PG8_SB(1, 0), b3, voffB); PG8_STAGE(PG8_SB(1, 1), b3 + hstep, voffB); PG8_STAGE(PG8_SA(1, 0), a3, voffA);
            PG8_WAIT_V(8); PG8_WAIT_L(0); PG8_BAR; PG8_MMA(1, 0, At, B0); PG8_MMA(1, 1, At, B1); PG8_BAR; PG8_SCHED;
            } else {
            PG8_LDB(B0, 0, 0); PG8_SCHED; PG8_LDA(At, 0, 0); PG8_STAGE(PG8_SA(1, 1), a1 + hstep, voffA);
            PG8_WAIT_L(8); PG8_BAR; PG8_WAIT_L(0); PG8_MMA(0, 0, At, B0); PG8_BAR; PG8_SCHED;
            PG8_LDB(B1, 0, 1); PG8_STAGE(PG8_SB(0, 0), b2, voffB);
            PG8_BAR; PG8_WAIT_L(0); PG8_MMA(0, 1, At, B1); PG8_BAR;
            PG8_LDA(At, 0, 1); PG8_STAGE(PG8_SA(0, 0), a2, voffA);
            PG8_BAR; PG8_WAIT_L(0); PG8_MMA(1, 0, At, B0); PG8_BAR; PG8_SCHED;
            PG8_STAGE(PG8_SB(0, 1), b2 + hstep, voffB);
            PG8_WAIT_V(6); PG8_BAR; PG8_MMA(1, 1, At, B1); PG8_BAR;
            PG8_LDB(B0, 1, 0); PG8_SCHED; PG8_LDA(At, 1, 0); PG8_STAGE(PG8_SA(0, 1), a2 + hstep, voffA);
            PG8_WAIT_L(8); PG8_BAR; PG8_WAIT_L(0); PG8_MMA(0, 0, At, B0); PG8_BAR; PG8_SCHED;
            PG8_LDB(B1, 1, 1); PG8_STAGE(PG8_SB(1, 0), b3, voffB);
            PG8_BAR; PG8_WAIT_L(0); PG8_MMA(0, 1, At, B1); PG8_BAR;
            PG8_LDA(At, 1, 1); PG8_STAGE(PG8_SA(1, 0), a3, voffA);
            PG8_BAR; PG8_WAIT_L(0); PG8_MMA(1, 0, At, B0); PG8_BAR; PG8_SCHED;
            PG8_STAGE(PG8_SB(1, 1), b3 + hstep, voffB);
            PG8_WAIT_V(6); PG8_BAR; PG8_MMA(1, 1, At, B1); PG8_BAR;
            }
        }
        if constexpr (ALIGN_EPI) { if (wr == 0) PG8_BAR; }
        if constexpr (!Epi::AFTER_DRAIN) { E(acc, cur, wr, wc, fr, fq); S.done(cur); }
        if (!has_next) break;
#pragma unroll
        for (int a = 0; a < 2; ++a)
#pragma unroll
            for (int b = 0; b < 2; ++b)
#pragma unroll
                for (int m = 0; m < 4; ++m)
#pragma unroll
                    for (int n = 0; n < 2; ++n) acc[a][b][m][n] = (f32x4){0.f, 0.f, 0.f, 0.f};
        cur = nxt; cA = nA; cB = nB; ++ui;
        if constexpr (ALIGN_EPI) { if (wr == 1) PG8_BAR; }
    }
    PG8_WAIT_V(0);
    if constexpr (!ALIGN_EPI) { if (wr == 0) PG8_BAR; }
    PG8_BAR;
    if constexpr (Epi::AFTER_DRAIN) { E.fused(acc, cur, wr, wc, fr, fq, lds, wid, lane); S.done(cur); }
#undef PG8_SA
#undef PG8_SB
#undef PG8_STAGE
#undef PG8_LDA
#undef PG8_LDB
#undef PG8_MMA
#undef PG8_WAIT_V
#undef PG8_WAIT_L
#undef PG8_BAR
#undef PG8_SCHED
}
}
#define GAS __attribute__((address_space(1)))
#define LAS __attribute__((address_space(3)))
typedef unsigned short bf16;
typedef unsigned v4u __attribute__((ext_vector_type(4)));
typedef unsigned v2u __attribute__((ext_vector_type(2)));
typedef float f32x4 __attribute__((ext_vector_type(4)));
typedef short bf16x8 __attribute__((ext_vector_type(8)));

constexpr int M = 16384, D = 1024, SEQ = 2048, FF = 4096, NIN = 3072, INCOLS = 3104;
constexpr float EPS = 1e-6f;
constexpr size_t MiB = 1u << 20;
constexpr size_t WS_WIN = 2 * MiB, WS_WOUT = 8 * MiB, WS_W1 = 10 * MiB, WS_W2 = 18 * MiB, WS_WG = 26 * MiB, WS_G = 27 * MiB, WS_GC = 29 * MiB,
                 WS_XN = 32 * MiB, WS_U = 32 * MiB, WS_PQKV = 64 * MiB, WS_WW = 64 * MiB, WS_PZUV = 112 * MiB, WS_MIX = 160 * MiB, WS_QKVC = 192 * MiB, WS_H = 64 * MiB;
constexpr int LDS_BYTES = 135168;

__device__ __forceinline__ unsigned f2bf(float f) { unsigned u = __builtin_bit_cast(unsigned, f); return (u + 0x7fffu + ((u >> 16) & 1u)) >> 16; }
__device__ __forceinline__ unsigned pk2(float lo, float hi) { return pg8::cvt_pk_bf16(lo, hi); }
__device__ __forceinline__ float bflo(unsigned w) { return __builtin_bit_cast(float, w << 16); }
__device__ __forceinline__ float bfhi(unsigned w) { return __builtin_bit_cast(float, w & 0xffff0000u); }
__device__ __forceinline__ float bf2f(bf16 h) { return __builtin_bit_cast(float, (unsigned)h << 16); }
__device__ __forceinline__ float wave_sum(float v) {
#pragma unroll
    for (int o = 1; o < 64; o <<= 1) v += __shfl_xor(v, o);
    return v;
}
__device__ __forceinline__ float gelu_exact(float x) { return 0.5f * x * (1.f + erff(x * 0.70710678118654752f)); }
__device__ __forceinline__ float silu_f(float x) { return x / (1.f + __expf(-x)); }
#define MFMA16(a, b, c) __builtin_amdgcn_mfma_f32_16x16x32_bf16((a), (b), (c), 0, 0, 0)
__device__ __forceinline__ bf16x8 ldfrag(const LAS bf16* base, int row0, int k0, int lane) {
    return *(const LAS bf16x8*)(base + (row0 + (lane & 15)) * 72 + k0 + (lane >> 4) * 8);
}
#define LDS_WAIT() asm volatile("s_waitcnt lgkmcnt(0)" ::: "memory")

struct Args { const float* in[18]; float* out; unsigned char* ws; int ph_lo, ph_hi; };
#ifndef MK_DIAG_MEMSET
#define MK_DIAG_MEMSET 0
#endif
#ifndef MK_LAST
#define MK_LAST 11
#endif
#ifndef MK_MULTI
#define MK_MULTI 0
#endif

__device__ __forceinline__ void transpose_item(const float* W, int ldw, int col0, int ncols, int K, bf16* WT, int row_off, LAS float* scr, int item, int lane) {
    const int nblk = ncols / 32, kb = item / nblk, nb = item % nblk, k0 = 64 * kb, n0 = 32 * nb;
#pragma unroll 8
    for (int i = 0; i < 32; ++i) { const int kk = 2 * i + (lane >> 5); scr[kk * 33 + (lane & 31)] = W[(size_t)(k0 + kk) * ldw + col0 + n0 + (lane & 31)]; }
    LDS_WAIT(); asm volatile("" ::: "memory");
    const int c = lane & 7;
#pragma unroll
    for (int j = 0; j < 4; ++j) { const int n = (lane >> 3) + 8 * j; const LAS float* s = scr + (8 * c) * 33 + n;
        v4u o; o.x = pk2(s[0 * 33], s[1 * 33]); o.y = pk2(s[2 * 33], s[3 * 33]); o.z = pk2(s[4 * 33], s[5 * 33]); o.w = pk2(s[6 * 33], s[7 * 33]);
        *(v4u*)(WT + (size_t)(row_off + n0 + n) * K + k0 + 8 * c) = o; }
    LDS_WAIT(); asm volatile("" ::: "memory");
}
__device__ __forceinline__ void rms_row_to_bf16(const float* xrow, const float* gain, bf16* orow, int lane) {
    const f32x4* xr = (const f32x4*)xrow + lane; const f32x4* gr = (const f32x4*)gain + lane;
    f32x4 v[4]; float s = 0.f;
#pragma unroll
    for (int j = 0; j < 4; ++j) { v[j] = xr[64 * j]; s += (v[j].x * v[j].x + v[j].y * v[j].y) + (v[j].z * v[j].z + v[j].w * v[j].w); }
    const float rstd = rsqrtf(wave_sum(s) * (1.f / D) + EPS);
    v2u* o8 = (v2u*)orow + lane;
#pragma unroll
    for (int j = 0; j < 4; ++j) { const f32x4 g = gr[64 * j]; v2u o; o.x = pk2(v[j].x * rstd * g.x, v[j].y * rstd * g.y); o.y = pk2(v[j].z * rstd * g.z, v[j].w * rstd * g.w); o8[64 * j] = o; }
}
__device__ __forceinline__ void rms_row_f32_inplace(float* xrow, const float* gain, int lane) {
    f32x4* xr = (f32x4*)xrow + lane; const f32x4* gr = (const f32x4*)gain + lane;
    f32x4 v[4]; float s = 0.f;
#pragma unroll
    for (int j = 0; j < 4; ++j) { v[j] = xr[64 * j]; s += (v[j].x * v[j].x + v[j].y * v[j].y) + (v[j].z * v[j].z + v[j].w * v[j].w); }
    const float rstd = rsqrtf(wave_sum(s) * (1.f / D) + EPS);
#pragma unroll
    for (int j = 0; j < 4; ++j) { const f32x4 g = gr[64 * j]; xr[64 * j] = v[j] * rstd * g; }
}
__device__ __forceinline__ void p0_prep(const Args& a, LAS unsigned char* lds, int G, int wave, int lane) {
    unsigned char* ws = a.ws;
    LAS float* scr = (LAS float*)(lds + wave * 16384);
    const int gw = blockIdx.x * 8 + wave, NGW = G * 8;
    constexpr int I_A = 16 * 64, I_B = 16 * 32, I_G = 16, I_O = 16 * 32, I_1 = 16 * 128, I_2 = 64 * 32;
    constexpr int NITEMS = I_A + I_B + I_G + I_O + I_1 + I_2;
    for (int it = gw; it < NITEMS; it += NGW) {
        int r = it;
        if (r < I_A) { transpose_item(a.in[2], INCOLS, 0, 2048, D, (bf16*)(ws + WS_WIN), 0, scr, r, lane); continue; } r -= I_A;
        if (r < I_B) { transpose_item(a.in[2], INCOLS, 2080, 1024, D, (bf16*)(ws + WS_WIN), 2048, scr, r, lane); continue; } r -= I_B;
        if (r < I_G) { transpose_item(a.in[2], INCOLS, 2048, 32, D, (bf16*)(ws + WS_WG), 0, scr, r, lane); continue; } r -= I_G;
        if (r < I_O) { transpose_item(a.in[13], D, 0, D, D, (bf16*)(ws + WS_WOUT), 0, scr, r, lane); continue; } r -= I_O;
        if (r < I_1) { transpose_item(a.in[15], FF, 0, FF, D, (bf16*)(ws + WS_W1), 0, scr, r, lane); continue; } r -= I_1;
        transpose_item(a.in[16], D, 0, D, FF, (bf16*)(ws + WS_W2), 0, scr, r, lane);
    }
    for (int m = gw; m < M; m += NGW) rms_row_to_bf16(a.in[0] + (size_t)m * D, a.in[1], (bf16*)(ws + WS_XN) + (size_t)m * D, lane);
}

__device__ __forceinline__ void p1_gates(const Args& a, int G, int wave, int lane) {
    const bf16* XN = (const bf16*)(a.ws + WS_XN); const bf16* WG = (const bf16*)(a.ws + WS_WG); float* Gt = (float*)(a.ws + WS_G);
    const int gw = blockIdx.x * 8 + wave, NGW = G * 8;
    for (int t = gw; t < 2048; t += NGW) { const int rt = t >> 1, ct = t & 1;
        const bf16* ap = XN + (size_t)(rt * 16 + (lane & 15)) * D + (lane >> 4) * 8;
        const bf16* bp = WG + (size_t)(ct * 16 + (lane & 15)) * D + (lane >> 4) * 8;
        f32x4 acc = {0.f, 0.f, 0.f, 0.f};
#pragma unroll 8
        for (int k0 = 0; k0 < D; k0 += 32) { const bf16x8 av = *(const bf16x8*)(ap + k0), bv = *(const bf16x8*)(bp + k0); acc = MFMA16(av, bv, acc); }
#pragma unroll
        for (int j = 0; j < 4; ++j) Gt[(size_t)(rt * 16 + (lane >> 4) * 4 + j) * 32 + ct * 16 + (lane & 15)] = acc[j];
    }
}

__device__ __forceinline__ void p2_conv(const Args& a, int G, int wave, int lane, int tid) {
    const bf16* PQ = (const bf16*)(a.ws + WS_PQKV); bf16* QC = (bf16*)(a.ws + WS_QKVC); const float* cwb = a.in[3];
    const int gw = blockIdx.x * 8 + wave, NGW = G * 8;
    for (int item = gw; item < 6144; item += NGW) {
        const int slot = item >> 11, run = item & 2047, m0 = run * 8, s0 = m0 & (SEQ - 1);
        const float* cw = cwb + slot * 512 + lane * 8;
        f32x4 w[5][2];
#pragma unroll
        for (int j = 0; j < 5; ++j) { w[j][0] = *(const f32x4*)(cw + j * 1536); w[j][1] = *(const f32x4*)(cw + j * 1536 + 4); }
        v4u xr[12];
#pragma unroll
        for (int r = 0; r < 12; ++r) { const int s = s0 - 2 + r; v4u z = {0u, 0u, 0u, 0u};
            if (s >= 0 && s < SEQ) z = *(const v4u*)(PQ + (size_t)(m0 - 2 + r) * 1536 + slot * 512 + lane * 8);
            xr[r] = z; }
#pragma unroll
        for (int r = 0; r < 8; ++r) {
            float acc[8];
#pragma unroll
            for (int e = 0; e < 8; ++e) acc[e] = 0.f;
#pragma unroll
            for (int j = 0; j < 5; ++j) { const v4u xv = xr[r + j];
#pragma unroll
                for (int e = 0; e < 4; ++e) { acc[2 * e] += w[j][e >> 1][(2 * e) & 3] * bflo(xv[e]); acc[2 * e + 1] += w[j][e >> 1][(2 * e + 1) & 3] * bfhi(xv[e]); } }
            float ss = 0.f;
#pragma unroll
            for (int e = 0; e < 8; ++e) { acc[e] = silu_f(acc[e]); ss += acc[e] * acc[e]; }
            float sc = 1.f;
            if (slot < 2) { ss += __shfl_xor(ss, 1); ss += __shfl_xor(ss, 2); ss += __shfl_xor(ss, 4); sc = rsqrtf(ss + EPS); if (slot == 0) sc *= 0.125f; }
            v4u o; o.x = pk2(acc[0] * sc, acc[1] * sc); o.y = pk2(acc[2] * sc, acc[3] * sc); o.z = pk2(acc[4] * sc, acc[5] * sc); o.w = pk2(acc[6] * sc, acc[7] * sc);
            *(v4u*)(QC + (size_t)(m0 + r) * 1536 + slot * 512 + lane * 8) = o;
        }
    }
    float* Gt = (float*)(a.ws + WS_G);
    for (int e = blockIdx.x * 512 + tid; e < M * 32; e += G * 512) { const int col = e & 31, h = col & 7, kind = col >> 3; float v = Gt[e];
        if (kind < 2) v = 1.f / (1.f + __expf(-v));
        else { const float al = (kind == 2 ? a.in[4] : a.in[6])[h], db = (kind == 2 ? a.in[5] : a.in[7])[h]; const float xx = v + db;
            v = -__expf(al) * (fmaxf(xx, 0.f) + log1pf(__expf(-fabsf(xx)))); }
        Gt[e] = v; }
}

__device__ __forceinline__ void p3_passA(const Args& a, LAS unsigned char* lds, int G, int tid, int lane) {
    const bf16* QC = (const bf16*)(a.ws + WS_QKVC); const float* Gt = (const float*)(a.ws + WS_G); float* GC = (float*)(a.ws + WS_GC);
    bf16* U = (bf16*)(a.ws + WS_U); bf16* Wb = (bf16*)(a.ws + WS_WW);
    const int sub = tid >> 7, c = tid & 127, wi = (tid >> 6) & 1;
    LAS unsigned char* reg = lds + sub * 26624;
    LAS bf16* ks = (LAS bf16*)reg; LAS float* Ls = (LAS float*)(reg + 9216); LAS float* bet = (LAS float*)(reg + 9216 + 16384); LAS float* gcs = bet + 64;
    for (int base = blockIdx.x * 4; base < 4096; base += G * 4) {
        const int item = base + sub, ci = item & 31, dir = (item >> 5) & 1, h = (item >> 6) & 7, b = item >> 9;
        const int rowbase = b * SEQ + (dir ? (SEQ - 1 - ci * 64) : ci * 64), rstep = dir ? -1 : 1;
        if (c < 64) { const int r = rowbase + rstep * c; const float be = Gt[(size_t)r * 32 + dir * 8 + h]; float g = Gt[(size_t)r * 32 + 16 + dir * 8 + h];
#pragma unroll
            for (int o = 1; o < 64; o <<= 1) { const float t = __shfl_up(g, o); if (lane >= o) g += t; }
            bet[c] = be; gcs[c] = g; GC[(size_t)item * 64 + c] = g; }
#pragma unroll
        for (int it = 0; it < 4; ++it) { const int id = it * 128 + c, i = id >> 3, dc = id & 7;
            const v4u kk = *(const v4u*)(QC + (size_t)(rowbase + rstep * i) * 1536 + 512 + h * 64 + dc * 8); *(LAS v4u*)(ks + i * 72 + dc * 8) = kk; }
        __syncthreads();
#pragma unroll
        for (int mt2 = 0; mt2 < 2; ++mt2) { const int mt = wi * 2 + mt2;
            for (int nt = 0; nt <= mt; ++nt) { f32x4 acc = {0.f, 0.f, 0.f, 0.f};
#pragma unroll
                for (int k2 = 0; k2 < 2; ++k2) { const bf16x8 av = ldfrag(ks, mt * 16, k2 * 32, lane), bv = ldfrag(ks, nt * 16, k2 * 32, lane); acc = MFMA16(av, bv, acc); }
                const int j = nt * 16 + (lane & 15); const float gj = gcs[j];
#pragma unroll
                for (int jj = 0; jj < 4; ++jj) { const int i = mt * 16 + (lane >> 4) * 4 + jj; const float val = bet[i] * acc[jj] * __expf(gcs[i] - gj); Ls[i * 64 + j] = (j < i) ? val : 0.f; } } }
        __syncthreads();
        float x[64];
        if (c < 64) { const bf16* vp = QC + (size_t)rowbase * 1536 + 1024 + h * 64 + c;
#pragma unroll
            for (int i = 0; i < 64; ++i) x[i] = bet[i] * bf2f(vp[(ptrdiff_t)(rstep * i) * 1536]); }
        else { const int d = c - 64;
#pragma unroll
            for (int i = 0; i < 64; ++i) x[i] = bet[i] * __expf(gcs[i]) * bf2f(ks[i * 72 + d]); }
#pragma unroll
        for (int i = 1; i < 64; ++i) { float s0 = x[i], s1 = 0.f;
#pragma unroll
            for (int j4 = 0; j4 < i; j4 += 4) { const f32x4 l = *(const LAS f32x4*)(Ls + i * 64 + j4);
                s0 -= l[0] * x[j4];
                if (j4 + 1 < i) s1 -= l[1] * x[j4 + 1];
                if (j4 + 2 < i) s0 -= l[2] * x[j4 + 2];
                if (j4 + 3 < i) s1 -= l[3] * x[j4 + 3]; }
            x[i] = s0 + s1; }
        if (c < 64) { v4u* up = (v4u*)(U + (size_t)item * 4096 + c * 64);
#pragma unroll
            for (int q = 0; q < 8; ++q) { v4u o; o.x = pk2(x[8 * q], x[8 * q + 1]); o.y = pk2(x[8 * q + 2], x[8 * q + 3]); o.z = pk2(x[8 * q + 4], x[8 * q + 5]); o.w = pk2(x[8 * q + 6], x[8 * q + 7]); up[q] = o; } }
        else { bf16* wp = Wb + (size_t)item * 4096 + (c - 64);
#pragma unroll
            for (int i = 0; i < 64; ++i) wp[i * 64] = (bf16)f2bf(x[i]); }
        __syncthreads();
    }
}

__device__ __forceinline__ void p4_passB(const Args& a, LAS unsigned char* lds, int seq, int tid, int wave, int lane) {
    const bf16* QC = (const bf16*)(a.ws + WS_QKVC); const float* GC = (const float*)(a.ws + WS_GC);
    const bf16* U = (const bf16*)(a.ws + WS_U); const bf16* Wb = (const bf16*)(a.ws + WS_WW);
    const int b = seq >> 4, h = (seq >> 1) & 7, dir = seq & 1;
    float* od = a.out + (size_t)dir * M * 512;
    LAS bf16* Qn = (LAS bf16*)lds; LAS bf16* Kn = Qn + 4608; LAS bf16* KdT = Kn + 4608; LAS bf16* Wl = KdT + 4608; LAS bf16* Att = Wl + 4608; LAS bf16* SbT = Att + 4608; LAS bf16* VnT = SbT + 4608;
    LAS float* gcs = (LAS float*)(VnT + 4608);
    const int it = wave >> 1, et0 = (wave & 1) * 2, li = tid >> 3, dc = tid & 7, fr = lane & 15, fq = lane >> 4;
    f32x4 accS[2] = {{0.f, 0.f, 0.f, 0.f}, {0.f, 0.f, 0.f, 0.f}};
    for (int u = tid; u < 2304; u += 512) ((LAS unsigned*)SbT)[u] = 0u;
    v4u q8, k8, w8; float gci, gcl; v2u ut[2];
#define LOADCHUNK(cidx) do { const int item_ = seq * 32 + (cidx); const int s_ = (cidx) * 64 + li; const size_t r_ = (size_t)(b * SEQ + (dir ? SEQ - 1 - s_ : s_)); \
        q8 = *(const v4u*)(QC + r_ * 1536 + h * 64 + dc * 8); k8 = *(const v4u*)(QC + r_ * 1536 + 512 + h * 64 + dc * 8); \
        w8 = *(const v4u*)(Wb + (size_t)item_ * 4096 + li * 64 + dc * 8); gci = GC[(size_t)item_ * 64 + li]; gcl = GC[(size_t)item_ * 64 + 63]; \
        _Pragma("unroll") for (int e2 = 0; e2 < 2; ++e2) ut[e2] = *(const v2u*)(U + (size_t)item_ * 4096 + ((et0 + e2) * 16 + fr) * 64 + it * 16 + fq * 4); } while (0)
    LOADCHUNK(0);
    for (int ci = 0; ci < 32; ++ci) {
        { const float eg = __expf(gcl - gci);
          *(LAS v4u*)(Qn + li * 72 + dc * 8) = q8; *(LAS v4u*)(Kn + li * 72 + dc * 8) = k8; *(LAS v4u*)(Wl + li * 72 + dc * 8) = w8;
#pragma unroll
          for (int e = 0; e < 4; ++e) { KdT[(dc * 8 + 2 * e) * 72 + li] = (bf16)f2bf(bflo(k8[e]) * eg); KdT[(dc * 8 + 2 * e + 1) * 72 + li] = (bf16)f2bf(bfhi(k8[e]) * eg); }
          if (dc == 0) gcs[li] = gci; }
        const float gl = __expf(gcl);
        const v2u utc0 = ut[0], utc1 = ut[1];
        __syncthreads();
        if (ci + 1 < 32) LOADCHUNK(ci + 1);
#pragma unroll
        for (int e2 = 0; e2 < 2; ++e2) {
            const int jt = et0 + e2; f32x4 acc = {0.f, 0.f, 0.f, 0.f};
#pragma unroll
            for (int k2 = 0; k2 < 2; ++k2) { const bf16x8 av = ldfrag(Kn, jt * 16, k2 * 32, lane), bv = ldfrag(Qn, it * 16, k2 * 32, lane); acc = MFMA16(av, bv, acc); }
            const int i = it * 16 + fr, j0 = jt * 16 + fq * 4; const float gi = gcs[i]; float val[4];
#pragma unroll
            for (int jj = 0; jj < 4; ++jj) { const float t = acc[jj] * __expf(gi - gcs[j0 + jj]); val[jj] = (j0 + jj <= i) ? t : 0.f; }
            v2u o; o.x = pk2(val[0], val[1]); o.y = pk2(val[2], val[3]); *(LAS v2u*)(Att + i * 72 + j0) = o;
        }
#pragma unroll
        for (int e2 = 0; e2 < 2; ++e2) {
            const int et = et0 + e2; f32x4 acc = {0.f, 0.f, 0.f, 0.f};
#pragma unroll
            for (int k2 = 0; k2 < 2; ++k2) { const bf16x8 av = ldfrag(Wl, it * 16, k2 * 32, lane), bv = ldfrag(SbT, et * 16, k2 * 32, lane); acc = MFMA16(av, bv, acc); }
            const v2u uu = e2 ? utc1 : utc0;
            v2u o; o.x = pk2(bflo(uu.x) - acc[0], bfhi(uu.x) - acc[1]); o.y = pk2(bflo(uu.y) - acc[2], bfhi(uu.y) - acc[3]);
            *(LAS v2u*)(VnT + (et * 16 + fr) * 72 + it * 16 + fq * 4) = o;
        }
        __syncthreads();
        { const int i = it * 16 + fr; const int s = ci * 64 + i; const size_t r = (size_t)(b * SEQ + (dir ? SEQ - 1 - s : s)); const float egi = __expf(gcs[i]);
#pragma unroll
          for (int e2 = 0; e2 < 2; ++e2) {
            const int et = et0 + e2; f32x4 acc = {0.f, 0.f, 0.f, 0.f};
#pragma unroll
            for (int k2 = 0; k2 < 2; ++k2) { const bf16x8 aq = ldfrag(Qn, it * 16, k2 * 32, lane), bs = ldfrag(SbT, et * 16, k2 * 32, lane); acc = MFMA16(bs, aq, acc); }
            acc = acc * egi;
#pragma unroll
            for (int k2 = 0; k2 < 2; ++k2) { const bf16x8 aa = ldfrag(Att, it * 16, k2 * 32, lane), bv = ldfrag(VnT, et * 16, k2 * 32, lane); acc = MFMA16(bv, aa, acc); }
            *(f32x4*)(od + r * 512 + h * 64 + et * 16 + fq * 4) = acc;
          } }
#pragma unroll
        for (int e2 = 0; e2 < 2; ++e2) {
            const int et = et0 + e2; accS[e2] = accS[e2] * gl;
#pragma unroll
            for (int k2 = 0; k2 < 2; ++k2) { const bf16x8 av = ldfrag(KdT, it * 16, k2 * 32, lane), bv = ldfrag(VnT, et * 16, k2 * 32, lane); accS[e2] = MFMA16(av, bv, accS[e2]); }
        }
        __syncthreads();
#pragma unroll
        for (int e2 = 0; e2 < 2; ++e2) { v2u o; o.x = pk2(accS[e2][0], accS[e2][1]); o.y = pk2(accS[e2][2], accS[e2][3]); *(LAS v2u*)(SbT + ((et0 + e2) * 16 + fr) * 72 + it * 16 + fq * 4) = o; }
    }
#undef LOADCHUNK
    __syncthreads();
}

__device__ __forceinline__ void p4_sgu(const Args& a, LAS unsigned char* lds, int unit, int tid, int wave, int lane) {
    const bf16* PZ = (const bf16*)(a.ws + WS_PZUV); bf16* MIX = (bf16*)(a.ws + WS_MIX);
    const int g = unit & 3, n = (unit >> 2) & 15, b = unit >> 6, m0 = b * SEQ + n * 128, fr = lane & 15, fq = lane >> 4;
    LAS bf16* VT = (LAS bf16*)lds; LAS bf16* WS = VT + 128 * 136;
#pragma unroll
    for (int it = 0; it < 4; ++it) { const int id = it * 512 + tid, r = id >> 4, cc = id & 15;
        const v4u raw = *(const v4u*)(PZ + (size_t)(m0 + r) * 1536 + 1024 + g * 128 + cc * 8);
        float f[8]; float ss = 0.f;
#pragma unroll
        for (int e = 0; e < 4; ++e) { f[2 * e] = gelu_exact(bflo(raw[e])); f[2 * e + 1] = gelu_exact(bfhi(raw[e])); ss += f[2 * e] * f[2 * e] + f[2 * e + 1] * f[2 * e + 1]; }
        ss += __shfl_xor(ss, 1); ss += __shfl_xor(ss, 2); ss += __shfl_xor(ss, 4); ss += __shfl_xor(ss, 8);
        const float rs = rsqrtf(ss * (1.f / 128.f) + EPS); const float* vg = a.in[9] + g * 128 + cc * 8;
#pragma unroll
        for (int e = 0; e < 8; ++e) VT[(cc * 8 + e) * 136 + r] = (bf16)f2bf(f[e] * rs * vg[e]); }
#pragma unroll
    for (int it = 0; it < 8; ++it) { const int id = it * 512 + tid, t = id >> 5, s4 = id & 31;
        const f32x4 w = *(const f32x4*)(a.in[10] + (size_t)g * 16384 + t * 128 + s4 * 4); v2u o; o.x = pk2(w.x, w.y); o.y = pk2(w.z, w.w); *(LAS v2u*)(WS + t * 136 + s4 * 4) = o; }
    __syncthreads();
    const int t0 = wave * 16;
    f32x4 acc[8];
#pragma unroll
    for (int nt = 0; nt < 8; ++nt) acc[nt] = (f32x4){0.f, 0.f, 0.f, 0.f};
#pragma unroll
    for (int k4 = 0; k4 < 4; ++k4) { const bf16x8 av = *(const LAS bf16x8*)(WS + (t0 + fr) * 136 + k4 * 32 + fq * 8);
#pragma unroll
        for (int nt = 0; nt < 8; ++nt) { const bf16x8 bv = *(const LAS bf16x8*)(VT + (nt * 16 + fr) * 136 + k4 * 32 + fq * 8); acc[nt] = MFMA16(av, bv, acc[nt]); } }
#pragma unroll
    for (int j = 0; j < 4; ++j) { const int t = t0 + fq * 4 + j; const float bias = a.in[11][g * 128 + t];
        const bf16* up = PZ + (size_t)(m0 + t) * 1536 + 512 + g * 128 + fr; float val[8]; float ss = 0.f;
#pragma unroll
        for (int nt = 0; nt < 8; ++nt) { val[nt] = gelu_exact(bf2f(up[nt * 16])) * (acc[nt][j] + bias); ss += val[nt] * val[nt]; }
        ss += __shfl_xor(ss, 1); ss += __shfl_xor(ss, 2); ss += __shfl_xor(ss, 4); ss += __shfl_xor(ss, 8);
        const float rs = rsqrtf(ss * (1.f / 128.f) + EPS); const float* og = a.in[12] + g * 128 + fr; bf16* mp = MIX + (size_t)(m0 + t) * 1024 + 512 + g * 128 + fr;
#pragma unroll
        for (int nt = 0; nt < 8; ++nt) mp[nt * 16] = (bf16)f2bf(val[nt] * rs * og[nt * 16]); }
    __syncthreads();
}

__device__ __forceinline__ void p5_gnorm(const Args& a, int G, int wave, int lane) {
    const bf16* PZ = (const bf16*)(a.ws + WS_PZUV); bf16* MIX = (bf16*)(a.ws + WS_MIX);
    const int gw = blockIdx.x * 8 + wave, NGW = G * 8;
    const f32x4 g0 = *(const f32x4*)(a.in[8] + (lane & 7) * 8), g1 = *(const f32x4*)(a.in[8] + (lane & 7) * 8 + 4);
    for (int m = gw; m < M; m += NGW) {
        const float* of = a.out + (size_t)m * 512 + lane * 8; const float* ob = of + (size_t)M * 512;
        const f32x4 o0 = *(const f32x4*)of + *(const f32x4*)ob, o1 = *(const f32x4*)(of + 4) + *(const f32x4*)(ob + 4);
        float ss = (o0.x * o0.x + o0.y * o0.y) + (o0.z * o0.z + o0.w * o0.w) + (o1.x * o1.x + o1.y * o1.y) + (o1.z * o1.z + o1.w * o1.w);
        ss += __shfl_xor(ss, 1); ss += __shfl_xor(ss, 2); ss += __shfl_xor(ss, 4);
        const float rs = rsqrtf(ss * (1.f / 64.f) + EPS);
        const v4u zz = *(const v4u*)(PZ + (size_t)m * 1536 + lane * 8);
        v4u o;
        o.x = pk2(o0.x * rs * g0.x * silu_f(bflo(zz.x)), o0.y * rs * g0.y * silu_f(bfhi(zz.x)));
        o.y = pk2(o0.z * rs * g0.z * silu_f(bflo(zz.y)), o0.w * rs * g0.w * silu_f(bfhi(zz.y)));
        o.z = pk2(o1.x * rs * g1.x * silu_f(bflo(zz.z)), o1.y * rs * g1.y * silu_f(bfhi(zz.z)));
        o.w = pk2(o1.z * rs * g1.z * silu_f(bflo(zz.w)), o1.w * rs * g1.w * silu_f(bfhi(zz.w)));
        *(v4u*)(MIX + (size_t)m * 1024 + lane * 8) = o;
    }
}

__global__ void __launch_bounds__(512, 2) fwd_mega(Args a) {
    extern __shared__ __attribute__((aligned(16))) unsigned char lds_raw[];
    LAS unsigned char* lds = (LAS unsigned char*)lds_raw;
    cg::grid_group grid = cg::this_grid();
#define GSYNC() do { asm volatile("s_waitcnt vmcnt(0) lgkmcnt(0)" ::: "memory"); grid.sync(); __builtin_amdgcn_fence(__ATOMIC_ACQUIRE, "agent"); asm volatile("s_waitcnt vmcnt(0)" ::: "memory"); __syncthreads(); } while (0)
    const int tid = threadIdx.x, lane = tid & 63, wave = __builtin_amdgcn_readfirstlane(tid >> 6), G = gridDim.x, bid = blockIdx.x;
    unsigned char* ws = a.ws;
    const int gw = bid * 8 + wave, NGW = G * 8;

#define IN(k) (a.ph_lo <= (k) && (k) < a.ph_hi)
#define SEAM(k) do { if (IN(k) && IN((k) + 1)) GSYNC(); } while (0)
    if (IN(0)) p0_prep(a, lds, G, wave, lane);
    SEAM(0);
    if (IN(1)) {
        pg8::Gemm g{(const pg8::bf16_t*)(ws + WS_XN), (const pg8::bf16_t*)(ws + WS_WIN), M, NIN, D}; pg8::StaticOrder S; S.init(M, NIN, G, bid);
        pg8::EpiBf16<0> E{(pg8::bf16_t*)(ws + WS_PQKV), 1536, 1536, (size_t)(WS_PZUV - WS_PQKV) / 2};
        pg8::gemm_phase<pg8::EpiBf16<0>, pg8::StaticOrder, true, true>(lds, g, S, E);
        p1_gates(a, G, wave, lane);
    }
    SEAM(1);
    if (IN(2)) p2_conv(a, G, wave, lane, tid);
    SEAM(2);
    if (IN(3)) p3_passA(a, lds, G, tid, lane);
    SEAM(3);
    if (IN(4)) {
        if (G >= 256) { if (bid < 128) p4_passB(a, lds, bid, tid, wave, lane); else for (int u = bid - 128; u < 512; u += G - 128) p4_sgu(a, lds, u, tid, wave, lane); }
        else { for (int s = bid; s < 128; s += G) p4_passB(a, lds, s, tid, wave, lane); for (int u = bid; u < 512; u += G) p4_sgu(a, lds, u, tid, wave, lane); }
    }
    SEAM(4);
    if (IN(5)) p5_gnorm(a, G, wave, lane);
    SEAM(5);
    if (IN(6)) {
        pg8::Gemm g{(const pg8::bf16_t*)(ws + WS_MIX), (const pg8::bf16_t*)(ws + WS_WOUT), M, D, D}; pg8::StaticOrder S; S.init(M, D, G, bid);
        pg8::EpiResF32 E{a.in[0], a.out, D};
        pg8::gemm_phase<pg8::EpiResF32, pg8::StaticOrder, true, true>(lds, g, S, E);
    }
    SEAM(6);
    if (IN(7)) for (int m = gw; m < M; m += NGW) rms_row_to_bf16(a.out + (size_t)m * D, a.in[14], (bf16*)(ws + WS_XN) + (size_t)m * D, lane);
    SEAM(7);
    if (IN(8)) {
        pg8::Gemm g{(const pg8::bf16_t*)(ws + WS_XN), (const pg8::bf16_t*)(ws + WS_W1), M, FF, D}; pg8::StaticOrder S; S.init(M, FF, G, bid);
        pg8::EpiBf16<2> E{(pg8::bf16_t*)(ws + WS_H), FF, 0, 0};
        pg8::gemm_phase<pg8::EpiBf16<2>, pg8::StaticOrder, true, true>(lds, g, S, E);
    }
    SEAM(8);
    if (IN(9)) {
        pg8::Gemm g{(const pg8::bf16_t*)(ws + WS_H), (const pg8::bf16_t*)(ws + WS_W2), M, D, FF}; pg8::StaticOrder S; S.init(M, D, G, bid);
        pg8::EpiResF32 E{a.out, a.out, D};
        pg8::gemm_phase<pg8::EpiResF32, pg8::StaticOrder, true, true>(lds, g, S, E);
    }
    SEAM(9);
    if (IN(10)) for (int m = gw; m < M; m += NGW) rms_row_f32_inplace(a.out + (size_t)m * D, a.in[17], lane);
    if (a.ph_lo == 21) {
        const bf16* QC = (const bf16*)(ws + WS_QKVC); const float* Gt = (const float*)(ws + WS_G);
        for (size_t e = (size_t)bid * 512 + tid; e < (size_t)M * D; e += (size_t)G * 512) { const size_t m = e >> 10; const int c = (int)(e & 1023);
            a.out[e] = bf2f(QC[m * 1536 + c]) + (c < 512 ? bf2f(QC[m * 1536 + 1024 + c]) : Gt[m * 32 + (c & 31)]); } }
    if (a.ph_lo == 22) {
        const bf16* U = (const bf16*)(ws + WS_U); const bf16* Wb = (const bf16*)(ws + WS_WW); const float* GC = (const float*)(ws + WS_GC);
        for (size_t e = (size_t)bid * 512 + tid; e < (size_t)M * D; e += (size_t)G * 512) a.out[e] = bf2f(U[e]) + bf2f(Wb[e]) + GC[e & 262143]; }
    if (a.ph_lo == 20) {
        const bf16* PQ = (const bf16*)(ws + WS_PQKV); const bf16* PZ = (const bf16*)(ws + WS_PZUV); const float* Gt = (const float*)(ws + WS_G);
        for (size_t e = (size_t)bid * 512 + tid; e < (size_t)M * D; e += (size_t)G * 512) { const size_t m = e >> 10; const int c = (int)(e & 1023);
            a.out[e] = bf2f(PQ[m * 1536 + c]) + bf2f(PZ[m * 1536 + c]) + (c < 512 ? bf2f(PQ[m * 1536 + 1024 + c]) + bf2f(PZ[m * 1536 + 1024 + c]) : Gt[m * 32 + (c & 31)]); } }
}

extern "C" void kernel_launch(void* const* d_in, const int* in_sizes, int n_in, void* d_out, int out_size, void* d_ws, size_t ws_size, hipStream_t stream) {
    static int grid_blocks = 0;
    if (grid_blocks == 0) {
        int dev = 0, cus = 0, per_cu = 0;
        (void)hipGetDevice(&dev);
        (void)hipDeviceGetAttribute(&cus, hipDeviceAttributeMultiprocessorCount, dev);
        if (hipFuncSetAttribute((const void*)fwd_mega, hipFuncAttributeMaxDynamicSharedMemorySize, LDS_BYTES) != hipSuccess) fprintf(stderr, "hipFuncSetAttribute failed\n");
        if (hipOccupancyMaxActiveBlocksPerMultiprocessor(&per_cu, (const void*)fwd_mega, 512, LDS_BYTES) != hipSuccess || per_cu < 1) { fprintf(stderr, "occupancy query: %d\n", per_cu); per_cu = 1; }
        (void)hipGetLastError();
        grid_blocks = cus * per_cu;
        if (n_in != 18 || ws_size < 256 * MiB) fprintf(stderr, "kernel_launch: unexpected n_in %d / ws %zu\n", n_in, ws_size);
    }
    Args a{};
    for (int i = 0; i < 18; ++i) a.in[i] = (const float*)d_in[i];
    a.out = (float*)d_out; a.ws = (unsigned char*)d_ws;
    void* args[] = {&a};
#if MK_DIAG_MEMSET
    (void)hipMemsetAsync(d_ws, 0, 256 * MiB, stream); (void)hipMemsetAsync(d_out, 0, (size_t)M * D * 4, stream);
#endif
#if MK_MULTI
    for (int p = 0; p < MK_LAST; ++p) { a.ph_lo = p; a.ph_hi = p + 1;
        hipError_t e = hipLaunchCooperativeKernel((const void*)fwd_mega, dim3(grid_blocks), dim3(512), args, LDS_BYTES, stream);
        if (e != hipSuccess) fprintf(stderr, "launch %d failed: %s (grid %d)\n", p, hipGetErrorString(e), grid_blocks); }
#ifdef MK_DUMP
    a.ph_lo = MK_DUMP; a.ph_hi = MK_DUMP; (void)hipLaunchCooperativeKernel((const void*)fwd_mega, dim3(grid_blocks), dim3(512), args, LDS_BYTES, stream);
#endif
#else
    a.ph_lo = 0; a.ph_hi = 11;
    hipError_t e = hipLaunchCooperativeKernel((const void*)fwd_mega, dim3(grid_blocks), dim3(512), args, LDS_BYTES, stream);
    if (e != hipSuccess) fprintf(stderr, "cooperative launch failed: %s (grid %d)\n", hipGetErrorString(e), grid_blocks);
#endif
}
```

```cpp
#include <hip/hip_runtime.h>
#include <hip/hip_cooperative_groups.h>
#include <cstdio>
#include <cstdint>
namespace cg = cooperative_groups;
namespace pg8 {
#define PG8_LAS __attribute__((address_space(3)))
typedef unsigned short bf16_t;
typedef short bf16x8 __attribute__((ext_vector_type(8)));
typedef float f32x4 __attribute__((ext_vector_type(4)));
typedef unsigned u32x4 __attribute__((ext_vector_type(4)));
constexpr int BM = 256, BK = 64, HALF = 128, HTB = HALF * BK * 2  , STAGE_BYTES = 8 * HTB, NXCD = 8, WGM = 8;

__host__ __device__ __forceinline__ int lds_byte(int r, int c) { const int st = (r >> 4) * 2 + (c >> 5), rr = r & 15, cc = c & 31, ob = rr * 64 + cc * 2; return st * 1024 + (ob ^ (((ob >> 9) & 1) << 5)); }
__host__ __device__ __forceinline__ void stage_rc(int b, int& R, int& C) { const int st = b / 1024, sb = b % 1024, swz = sb ^ (((sb >> 9) & 1) << 5); R = (st >> 1) * 16 + swz / 64; C = (st & 1) * 32 + (swz % 64) / 2; }
__host__ __device__ __forceinline__ int perm32(int rho) { const int n = rho >> 4, i = rho & 15; return 8 * (i >> 2) + 4 * n + (i & 3); }

struct Unit { int pm, pn; };
struct Gemm { const bf16_t* A; const bf16_t* Bt; int M, N, K; };

struct StaticOrder {
    int nM, nN, nwg, G, c;
    __host__ __device__ void init(int M, int N, int G_, int c_) { nM = M / BM; nN = N / BM; nwg = nM * nN; G = G_; c = c_; }
    __host__ __device__ bool next(int i, Unit& u) const {
        const long L = (long)i * G + c; if (L >= nwg) return false;
        int wgid = (int)L; { const int q = nwg / NXCD, r = nwg % NXCD, xcd = wgid % NXCD, off = wgid / NXCD; wgid = (xcd < r ? xcd * (q + 1) : r * (q + 1) + (xcd - r) * q) + off; }
        const int nig = WGM * nN, gid = wgid / nig, fm = gid * WGM, gsz = (nM - fm) < WGM ? (nM - fm) : WGM;
        u.pm = fm + ((wgid % nig) % gsz); u.pn = (wgid % nig) / gsz; return true;
    }
    __device__ __forceinline__ void a_ready(const Unit&) const {}
    __device__ __forceinline__ void done(const Unit&) const {}
};

typedef float f32x2c_t __attribute__((ext_vector_type(2))); typedef __bf16 bf16x2c_t __attribute__((ext_vector_type(2)));
__device__ __forceinline__ unsigned cvt_pk_bf16(float lo, float hi) { f32x2c_t v = {lo, hi}; bf16x2c_t b = __builtin_convertvector(v, bf16x2c_t); return __builtin_bit_cast(unsigned, b); }
typedef float f32x2 __attribute__((ext_vector_type(2)));
__device__ __forceinline__ f32x2 gelu_pk(f32x2 v) {
    const f32x2 av = __builtin_elementwise_abs(v), d = av * 0.2316418882f + 1.0f;
    f32x2 t; t.x = __builtin_amdgcn_rcpf(d.x); t.y = __builtin_amdgcn_rcpf(d.y);
    f32x2 q = t * 0.5307027145f + (-0.7265760135f); q = q * t + 0.7107068705f; q = q * t + (-0.142248368f); q = q * t + 0.127414796f; q = q * t;
    const f32x2 s = (v * v) * (-0.72134752044f);
    f32x2 e; e.x = __builtin_amdgcn_exp2f(s.x); e.y = __builtin_amdgcn_exp2f(s.y);
    const f32x2 m = v * (q * e), r = v - m;
    f32x2 o; o.x = v.x < 0.f ? m.x : r.x; o.y = v.y < 0.f ? m.y : r.y; return o;
}
template <int ACT  > struct EpiBf16 {
    static constexpr bool PERM = true, AFTER_DRAIN = false;
    bf16_t* O; int ldc; int split_cols; size_t split_stride;
    __device__ __forceinline__ void operator()(const f32x4 (&acc)[2][2][4][2], const Unit& u, int wr, int wc, int fr, int fq) const {
        const int row0 = u.pm * BM + wr * 64 + fr; int colt = u.pn * BM; bf16_t* base = O;
        if (split_cols) { const int t = colt / split_cols; base += (size_t)t * split_stride; colt -= t * split_cols; }
        const int col0 = colt + wc * 32 + 8 * fq;
#pragma unroll
        for (int ai = 0; ai < 2; ++ai)
#pragma unroll
            for (int m = 0; m < 4; ++m) { bf16_t* rowp = base + (size_t)(row0 + ai * HALF + m * 16) * ldc + col0;
#pragma unroll
                for (int bj = 0; bj < 2; ++bj) { f32x4 v0 = acc[ai][bj][m][0], v1 = acc[ai][bj][m][1];
                    if (ACT == 2) {
#pragma unroll
                        for (int e = 0; e < 4; ++e) { float a = fmaxf(v0[e], 0.f), b = fmaxf(v1[e], 0.f); v0[e] = a * a; v1[e] = b * b; } }
                    u32x4 w; w.x = cvt_pk_bf16(v0[0], v0[1]); w.y = cvt_pk_bf16(v0[2], v0[3]); w.z = cvt_pk_bf16(v1[0], v1[1]); w.w = cvt_pk_bf16(v1[2], v1[3]);
                    *(u32x4*)(rowp + bj * HALF) = w; } }
    }
};
struct EpiResF32 {
    static constexpr bool PERM = false, AFTER_DRAIN = false;
    const float* base; float* out; int ldc;
    __device__ __forceinline__ void operator()(const f32x4 (&acc)[2][2][4][2], const Unit& u, int wr, int wc, int fr, int fq) const {
        const int col0 = u.pn * BM + wc * 32 + 4 * fq;
#pragma unroll
        for (int ai = 0; ai < 2; ++ai)
#pragma unroll
            for (int m = 0; m < 4; ++m) { const size_t off = (size_t)(u.pm * BM + ai * HALF + wr * 64 + m * 16 + fr) * ldc + col0;
#pragma unroll
                for (int bj = 0; bj < 2; ++bj)
#pragma unroll
                    for (int n = 0; n < 2; ++n) { const f32x4 bs = *(const f32x4*)(base + off + bj * HALF + n * 16); *(f32x4*)(out + off + bj * HALF + n * 16) = bs + acc[ai][bj][m][n]; } }
    }
};
template <class Epi, class Sched, bool ALIGN_EPI = false, bool SP2 = false>
__device__ __forceinline__ void gemm_phase(PG8_LAS unsigned char* lds, const Gemm g, const Sched& S, const Epi& E) {
    const int tid = threadIdx.x, wid = __builtin_amdgcn_readfirstlane(tid >> 6), lane = tid & 63, wr = wid >> 2, wc = wid & 3, fr = lane & 15, fq = lane >> 4;
    const int K = g.K, nt = K / BK;
    unsigned voffA[2], voffB[2];
#pragma unroll
    for (int i = 0; i < 2; ++i) { int R, C; stage_rc(tid * 16 + i * 8192, R, C); const int Rb = Epi::PERM ? ((R & ~31) + perm32(R & 31)) : R;
        voffA[i] = (unsigned)(R * K + C) * 2u; voffB[i] = (unsigned)(Rb * K + C) * 2u; }
    const size_t kstep = (size_t)(BK * 2);
    const size_t hstep = (size_t)HALF * K * 2;
    const size_t tstep = 2 * hstep;
    const unsigned ldsw = (unsigned)wid * 1024u;
    const int aoff = lds_byte(wr * 64 + fr, fq * 8), boff = lds_byte(wc * 32 + fr, fq * 8);
#define PG8_SA(b, h) (((b) * 2 + (h)) * HTB)
#define PG8_SB(b, h) ((4 + (b) * 2 + (h)) * HTB)
#define PG8_STAGE(bufoff, gbase, voff) do { _Pragma("unroll") for (int _i = 0; _i < 2; ++_i) \
        __builtin_amdgcn_global_load_lds((const unsigned*)((const char*)(gbase) + (voff)[_i]), (PG8_LAS unsigned*)(lds + (bufoff) + ldsw + _i * 8192), 16, 0, 0); } while (0)
#define PG8_LDA(dst, b, h) do { _Pragma("unroll") for (int m = 0; m < 4; ++m) _Pragma("unroll") for (int k = 0; k < 2; ++k) dst[m][k] = *(const PG8_LAS bf16x8*)(lds + PG8_SA(b, h) + aoff + m * 2048 + k * 1024); } while (0)
#define PG8_LDB(dst, b, h) do { _Pragma("unroll") for (int n = 0; n < 2; ++n) _Pragma("unroll") for (int k = 0; k < 2; ++k) dst[n][k] = *(const PG8_LAS bf16x8*)(lds + PG8_SB(b, h) + boff + n * 2048 + k * 1024); } while (0)
#define PG8_MMA(ai, bj, At, Bt) do { __builtin_amdgcn_s_setprio(1); _Pragma("unroll") for (int m = 0; m < 4; ++m) _Pragma("unroll") for (int n = 0; n < 2; ++n) _Pragma("unroll") for (int k = 0; k < 2; ++k) \
        acc[ai][bj][m][n] = __builtin_amdgcn_mfma_f32_16x16x32_bf16(Bt[n][k], At[m][k], acc[ai][bj][m][n], 0, 0, 0); __builtin_amdgcn_s_setprio(0); } while (0)
#define PG8_WAIT_V(n) asm volatile("s_waitcnt vmcnt(" #n ")" ::: "memory")
#define PG8_WAIT_L(n) asm volatile("s_waitcnt lgkmcnt(" #n ")" ::: "memory")
#define PG8_BAR __builtin_amdgcn_s_barrier()
#define PG8_SCHED __builtin_amdgcn_sched_barrier(0)
    Unit cur, nxt; int ui = 0;
    if (!S.next(0, cur)) return;
    f32x4 acc[2][2][4][2];
#pragma unroll
    for (int a = 0; a < 2; ++a)
#pragma unroll
        for (int b = 0; b < 2; ++b)
#pragma unroll
            for (int m = 0; m < 4; ++m)
#pragma unroll
                for (int n = 0; n < 2; ++n) acc[a][b][m][n] = (f32x4){0.f, 0.f, 0.f, 0.f};
    bf16x8 At[4][2], B0[2][2], B1[2][2];
    const char* cA = (const char*)g.A + (size_t)cur.pm * tstep; const char* cB = (const char*)g.Bt + (size_t)cur.pn * tstep;
    S.a_ready(cur);
    if constexpr (SP2) {
        PG8_STAGE(PG8_SB(0, 0), cB, voffB); PG8_STAGE(PG8_SB(0, 1), cB + hstep, voffB); PG8_STAGE(PG8_SA(0, 0), cA, voffA); PG8_STAGE(PG8_SA(0, 1), cA + hstep, voffA);
        if (wr == 1) PG8_BAR;
        PG8_WAIT_V(2); PG8_BAR;
        PG8_STAGE(PG8_SB(1, 0), cB + kstep, voffB); PG8_STAGE(PG8_SA(1, 0), cA + kstep, voffA); PG8_STAGE(PG8_SB(1, 1), cB + hstep + kstep, voffB);
        PG8_WAIT_V(6); PG8_BAR;
    } else {
        PG8_STAGE(PG8_SB(0, 0), cB, voffB); PG8_STAGE(PG8_SA(0, 0), cA, voffA); PG8_STAGE(PG8_SB(0, 1), cB + hstep, voffB); PG8_STAGE(PG8_SA(0, 1), cA + hstep, voffA);
        if (wr == 1) PG8_BAR;
        PG8_WAIT_V(4); PG8_BAR;
        PG8_STAGE(PG8_SB(1, 0), cB + kstep, voffB); PG8_STAGE(PG8_SA(1, 0), cA + kstep, voffA); PG8_STAGE(PG8_SB(1, 1), cB + hstep + kstep, voffB);
        PG8_WAIT_V(6); PG8_BAR;
    }
    for (;;) {
        const bool has_next = S.next(ui + 1, nxt);
        const char* nA = has_next ? (const char*)g.A + (size_t)nxt.pm * tstep : cA; const char* nB = has_next ? (const char*)g.Bt + (size_t)nxt.pn * tstep : cB;
        for (int t = 0; t < nt; t += 2) {
            const bool last = (t == nt - 2);
            const char* a1 = cA + (size_t)(t + 1) * kstep;
            const char* a2 = last ? nA : cA + (size_t)(t + 2) * kstep; const char* b2 = last ? nB : cB + (size_t)(t + 2) * kstep;
            const char* a3 = a2 + kstep; const char* b3 = b2 + kstep;
            if (last && has_next) S.a_ready(nxt);
            if constexpr (SP2) {
            PG8_LDB(B0, 0, 0); PG8_LDB(B1, 0, 1); PG8_SCHED; PG8_LDA(At, 0, 0); PG8_STAGE(PG8_SA(1, 1), a1 + hstep, voffA);
            PG8_WAIT_V(8); PG8_WAIT_L(0); PG8_BAR; PG8_MMA(0, 0, At, B0); PG8_MMA(0, 1, At, B1); PG8_BAR; PG8_SCHED;
            PG8_LDA(At, 0, 1); PG8_STAGE(PG8_SB(0, 0), b2, voffB); PG8_STAGE(PG8_SB(0, 1), b2 + hstep, voffB); PG8_STAGE(PG8_SA(0, 0), a2, voffA);
            PG8_WAIT_V(8); PG8_WAIT_L(0); PG8_BAR; PG8_MMA(1, 0, At, B0); PG8_MMA(1, 1, At, B1); PG8_BAR; PG8_SCHED;
            PG8_LDB(B0, 1, 0); PG8_LDB(B1, 1, 1); PG8_SCHED; PG8_LDA(At, 1, 0); PG8_STAGE(PG8_SA(0, 1), a2 + hstep, voffA);
            PG8_WAIT_V(8); PG8_WAIT_L(0); PG8_BAR; PG8_MMA(0, 0, At, B0); PG8_MMA(0, 1, At, B1); PG8_BAR; PG8_SCHED;
            PG8_LDA(At, 1, 1); PG8_STAGE(PG8_SB(1, 0), b3, voffB); PG8_STAGE(PG8_SB(1, 1), b3 + hstep, voffB); PG8_STAGE(PG8_SA(1, 0), a3, voffA);
            PG8_WAIT_V(8); PG8_WAIT_L(0); PG8_BAR; PG8_MMA(1, 0, At, B0); PG8_MMA(1, 1, At, B1); PG8_BAR; PG8_SCHED;
            } else {
            PG8_LDB(B0, 0, 0); PG8_SCHED; PG8_LDA(At, 0, 0); PG8_STAGE(PG8_SA(1, 1), a1 + hstep, voffA);
            PG8_WAIT_L(8); PG8_BAR; PG8_WAIT_L(0); PG8_MMA(0, 0, At, B0); PG8_BAR; PG8_SCHED;
            PG8_LDB(B1, 0, 1); PG8_STAGE(PG8_SB(0, 0), b2, voffB);
            PG8_BAR; PG8_WAIT_L(0); PG8_MMA(0, 1, At, B1); PG8_BAR;
            PG8_LDA(At, 0, 1); PG8_STAGE(PG8_SA(0, 0), a2, voffA);
            PG8_BAR; PG8_WAIT_L(0); PG8_MMA(1, 0, At, B0); PG8_BAR; PG8_SCHED;
            PG8_STAGE(PG8_SB(0, 1), b2 + hstep, voffB);
            PG8_WAIT_V(6); PG8_BAR; PG8_MMA(1, 1, At, B1); PG8_BAR;
            PG8_LDB(B0, 1, 0); PG8_SCHED; PG8_LDA(At, 1, 0); PG8_STAGE(PG8_SA(0, 1), a2 + hstep, voffA);
            PG8_WAIT_L(8); PG8_BAR; PG8_WAIT_L(0); PG8_MMA(0, 0, At, B0); PG8_BAR; PG8_SCHED;
            PG8_LDB(B1, 1, 1); PG8_STAGE(PG8_SB(1, 0), b3, voffB);
            PG8_BAR; PG8_WAIT_L(0); PG8_MMA(0, 1, At, B1); PG8_BAR;
            PG8_LDA(At, 1, 1); PG8_STAGE(PG8_SA(1, 0), a3, voffA);
            PG8_BAR; PG8_WAIT_L(0); PG8_MMA(1, 0, At, B0); PG8_BAR; PG8_SCHED;
            PG8_STAGE(PG8_SB(1, 1), b3 + hstep, voffB);
            PG8_WAIT_V(6); PG8_BAR; PG8_MMA(1, 1, At, B1); PG8_BAR;
            }
        }
        if constexpr (ALIGN_EPI) { if (wr == 0) PG8_BAR; }
        if constexpr (!Epi::AFTER_DRAIN) { E(acc, cur, wr, wc, fr, fq); S.done(cur); }
        if (!has_next) break;
#pragma unroll
        for (int a = 0; a < 2; ++a)
#pragma unroll
            for (int b = 0; b < 2; ++b)
#pragma unroll
                for (int m = 0; m < 4; ++m)
#pragma unroll
                    for (int n = 0; n < 2; ++n) acc[a][b][m][n] = (f32x4){0.f, 0.f, 0.f, 0.f};
        cur = nxt; cA = nA; cB = nB; ++ui;
        if constexpr (ALIGN_EPI) { if (wr == 1) PG8_BAR; }
    }
    PG8_WAIT_V(0);
    if constexpr (!ALIGN_EPI) { if (wr == 0) PG8_BAR; }
    PG8_BAR;
    if constexpr (Epi::AFTER_DRAIN) { E.fused(acc, cur, wr, wc, fr, fq, lds, wid, lane); S.done(cur); }
#undef PG8_SA
#undef PG8_SB
#undef PG8_STAGE
#undef PG8_LDA
#undef PG8_LDB
#undef PG8_MMA
#undef PG8_WAIT_V
#undef PG8_WAIT_L
#undef PG8_BAR
#undef PG8_SCHED
}
}
#define GAS __attribute__((address_space(1)))
#define LAS __attribute__((address_space(3)))
typedef unsigned short bf16;
typedef unsigned v4u __attribute__((ext_vector_type(4)));
typedef unsigned v2u __attribute__((ext_vector_type(2)));
typedef float f32x4 __attribute__((ext_vector_type(4)));
typedef short bf16x8 __attribute__((ext_vector_type(8)));

constexpr int M = 16384, D = 1024, SEQ = 2048, FF = 4096, NIN = 3072, INCOLS = 3104;
constexpr float EPS = 1e-6f;
constexpr size_t MiB = 1u << 20;
constexpr size_t WS_WIN = 2 * MiB, WS_WOUT = 8 * MiB, WS_W1 = 10 * MiB, WS_W2 = 18 * MiB, WS_WG = 26 * MiB, WS_G = 27 * MiB, WS_GC = 29 * MiB,
                 WS_XN = 32 * MiB, WS_U = 32 * MiB, WS_PQKV = 64 * MiB, WS_WW = 64 * MiB, WS_PZUV = 112 * MiB, WS_MIX = 160 * MiB, WS_QKVC = 192 * MiB, WS_H = 64 * MiB;
constexpr int LDS_BYTES = 135168;

__device__ __forceinline__ unsigned f2bf(float f) { unsigned u = __builtin_bit_cast(unsigned, f); return (u + 0x7fffu + ((u >> 16) & 1u)) >> 16; }
__device__ __forceinline__ unsigned pk2(float lo, float hi) { return pg8::cvt_pk_bf16(lo, hi); }
__device__ __forceinline__ float bflo(unsigned w) { return __builtin_bit_cast(float, w << 16); }
__device__ __forceinline__ float bfhi(unsigned w) { return __builtin_bit_cast(float, w & 0xffff0000u); }
__device__ __forceinline__ float bf2f(bf16 h) { return __builtin_bit_cast(float, (unsigned)h << 16); }
__device__ __forceinline__ float wave_sum(float v) {
#pragma unroll
    for (int o = 1; o < 64; o <<= 1) v += __shfl_xor(v, o);
    return v;
}
__device__ __forceinline__ float gelu_exact(float x) { return 0.5f * x * (1.f + erff(x * 0.70710678118654752f)); }
__device__ __forceinline__ float silu_f(float x) { return x / (1.f + __expf(-x)); }
#define MFMA16(a, b, c) __builtin_amdgcn_mfma_f32_16x16x32_bf16((a), (b), (c), 0, 0, 0)
__device__ __forceinline__ bf16x8 ldfrag(const LAS bf16* base, int row0, int k0, int lane) {
    return *(const LAS bf16x8*)(base + (row0 + (lane & 15)) * 72 + k0 + (lane >> 4) * 8);
}
#define LDS_WAIT() asm volatile("s_waitcnt lgkmcnt(0)" ::: "memory")
typedef GAS unsigned gu32;
#define XB_TMO      128
#define XB_XCNT(j)  (256  + 64 * (j))
#define XB_XSUB(j)  (1280 + 64 * (j))
#define XB_XGEN(j)  (2304 + 64 * (j))
#define XB_TOP      3328
#define XB_TOPGEN   3392
#define XCD_BAR_WORDS 3456
#define XB_SPIN_CAP (1u << 18)

__device__ __forceinline__ unsigned xb_ld(unsigned* p)              { return __hip_atomic_load(p, __ATOMIC_RELAXED, __HIP_MEMORY_SCOPE_AGENT); }
__device__ __forceinline__ unsigned xb_add(unsigned* p, unsigned v) { return __hip_atomic_fetch_add(p, v, __ATOMIC_RELAXED, __HIP_MEMORY_SCOPE_AGENT); }
__device__ __forceinline__ unsigned xb_xcc_id() { return (unsigned)__builtin_amdgcn_s_getreg((3 << 11) | 20) & 0xFu; }
#define XB_SPIN(cond, bar) do { unsigned _sp = 0; while (cond) { __builtin_amdgcn_s_sleep(1); \
    if ((++_sp & 255u) == 0u) { if (xb_ld(&(bar)[XB_TMO])) break; if (_sp > XB_SPIN_CAP) { atomicAdd(&(bar)[XB_TMO], 1u); break; } } } } while (0)

struct XcdBarrier {
    unsigned* bar; unsigned x;
    volatile LAS unsigned* st;
};

__device__ __forceinline__ XcdBarrier xcd_barrier_post(unsigned* bar, volatile LAS unsigned* st) {
    XcdBarrier b; b.bar = bar; b.x = xb_xcc_id(); b.st = st;
    if (threadIdx.x == 0) (void)xb_add(&bar[XB_XCNT(b.x)], 1u);
    return b;
}
__device__ __forceinline__ void xcd_barrier_complete(unsigned* bar, unsigned x, unsigned& nloc, unsigned& nx) {
    const unsigned G = gridDim.x * gridDim.y * gridDim.z;
    unsigned sum, cnt, mine, sp = 0u;
    for (;;) {
        sum = 0u; cnt = 0u; mine = 0u;
#pragma unroll
        for (unsigned j = 0; j < 16; ++j) { const unsigned c = xb_ld(&bar[XB_XCNT(j)]); sum += c; cnt += (c > 0u) ? 1u : 0u; mine = (j == x) ? c : mine; }
        if (sum == G) break;
        __builtin_amdgcn_s_sleep(1);
        if ((++sp & 255u) == 0u) { if (xb_ld(&bar[XB_TMO])) break; if (sp > XB_SPIN_CAP) { atomicAdd(&bar[XB_TMO], 1u); break; } }
    }
    nloc = mine > 0u ? mine : 1u; nx = cnt > 0u ? cnt : 1u;
}

__device__ __forceinline__ void xcd_barrier(const XcdBarrier& b) {
    asm volatile("s_waitcnt vmcnt(0)" ::: "memory");
    __syncthreads();
    if (threadIdx.x == 0) {
        unsigned* bar = b.bar;
        __builtin_amdgcn_s_waitcnt(0);
        unsigned nloc = b.st[0], nx = b.st[1];
        if (nloc == 0u) { xcd_barrier_complete(bar, b.x, nloc, nx); b.st[0] = nloc; b.st[1] = nx; }
        const unsigned old = xb_add(&bar[XB_XSUB(b.x)], 1u);
        const unsigned gen = old / nloc;
        if (old + 1u == (gen + 1u) * nloc) {
            __builtin_amdgcn_fence(__ATOMIC_RELEASE, "agent");
            asm volatile("s_waitcnt vmcnt(0)" ::: "memory");
            const unsigned og = xb_add(&bar[XB_TOP], 1u);
            const unsigned tg = og / nx;
            if (og + 1u == (tg + 1u) * nx) xb_add(&bar[XB_TOPGEN], 1u);
            else XB_SPIN(xb_ld(&bar[XB_TOPGEN]) == tg, bar);
            __builtin_amdgcn_fence(__ATOMIC_ACQUIRE, "agent");
            xb_add(&bar[XB_XGEN(b.x)], 1u);
            asm volatile("s_waitcnt vmcnt(0)" ::: "memory");
        } else {
            XB_SPIN(xb_ld(&bar[XB_XGEN(b.x)]) == gen, bar);
            __builtin_amdgcn_fence(__ATOMIC_ACQUIRE, "agent");
            asm volatile("s_waitcnt vmcnt(0)" ::: "memory");
        }
    }
    __syncthreads();
}


struct Args { const float* in[18]; float* out; unsigned char* ws; int ph_lo, ph_hi; };
#ifndef MK_DIAG_MEMSET
#define MK_DIAG_MEMSET 0
#endif
#ifndef MK_REP3
#define MK_REP3 1
#endif
#ifndef MK_REP4
#define MK_REP4 1
#endif
#ifndef MK_LAST
#define MK_LAST 11
#endif
#ifndef MK_MULTI
#define MK_MULTI 0
#endif

__device__ __forceinline__ void transpose_item(const float* W, int ldw, int col0, int ncols, int K, bf16* WT, int row_off, LAS float* scr, int item, int lane) {
    const int nblk = ncols / 32, kb = item / nblk, nb = item % nblk, k0 = 64 * kb, n0 = 32 * nb;
#pragma unroll 8
    for (int i = 0; i < 32; ++i) { const int kk = 2 * i + (lane >> 5); scr[kk * 33 + (lane & 31)] = W[(size_t)(k0 + kk) * ldw + col0 + n0 + (lane & 31)]; }
    LDS_WAIT(); asm volatile("" ::: "memory");
    const int c = lane & 7;
#pragma unroll
    for (int j = 0; j < 4; ++j) { const int n = (lane >> 3) + 8 * j; const LAS float* s = scr + (8 * c) * 33 + n;
        v4u o; o.x = pk2(s[0 * 33], s[1 * 33]); o.y = pk2(s[2 * 33], s[3 * 33]); o.z = pk2(s[4 * 33], s[5 * 33]); o.w = pk2(s[6 * 33], s[7 * 33]);
        *(v4u*)(WT + (size_t)(row_off + n0 + n) * K + k0 + 8 * c) = o; }
    LDS_WAIT(); asm volatile("" ::: "memory");
}
__device__ __forceinline__ void rms_row_to_bf16(const float* xrow, const float* gain, bf16* orow, int lane) {
    const f32x4* xr = (const f32x4*)xrow + lane; const f32x4* gr = (const f32x4*)gain + lane;
    f32x4 v[4]; float s = 0.f;
#pragma unroll
    for (int j = 0; j < 4; ++j) { v[j] = xr[64 * j]; s += (v[j].x * v[j].x + v[j].y * v[j].y) + (v[j].z * v[j].z + v[j].w * v[j].w); }
    const float rstd = rsqrtf(wave_sum(s) * (1.f / D) + EPS);
    v2u* o8 = (v2u*)orow + lane;
#pragma unroll
    for (int j = 0; j < 4; ++j) { const f32x4 g = gr[64 * j]; v2u o; o.x = pk2(v[j].x * rstd * g.x, v[j].y * rstd * g.y); o.y = pk2(v[j].z * rstd * g.z, v[j].w * rstd * g.w); o8[64 * j] = o; }
}
__device__ __forceinline__ void rms_row_f32_inplace(float* xrow, const float* gain, int lane) {
    f32x4* xr = (f32x4*)xrow + lane; const f32x4* gr = (const f32x4*)gain + lane;
    f32x4 v[4]; float s = 0.f;
#pragma unroll
    for (int j = 0; j < 4; ++j) { v[j] = xr[64 * j]; s += (v[j].x * v[j].x + v[j].y * v[j].y) + (v[j].z * v[j].z + v[j].w * v[j].w); }
    const float rstd = rsqrtf(wave_sum(s) * (1.f / D) + EPS);
#pragma unroll
    for (int j = 0; j < 4; ++j) { const f32x4 g = gr[64 * j]; xr[64 * j] = v[j] * rstd * g; }
}
__device__ __forceinline__ void p0_prep(const Args& a, LAS unsigned char* lds, int G, int wave, int lane) {
    unsigned char* ws = a.ws;
    LAS float* scr = (LAS float*)(lds + wave * 16384);
    const int gw = blockIdx.x * 8 + wave, NGW = G * 8;
    constexpr int I_A = 16 * 64, I_B = 16 * 32, I_G = 16, I_O = 16 * 32, I_1 = 16 * 128, I_2 = 64 * 32;
    constexpr int NITEMS = I_A + I_B + I_G + I_O + I_1 + I_2;
    for (int it = gw; it < NITEMS; it += NGW) {
        int r = it;
        if (r < I_A) { transpose_item(a.in[2], INCOLS, 0, 2048, D, (bf16*)(ws + WS_WIN), 0, scr, r, lane); continue; } r -= I_A;
        if (r < I_B) { transpose_item(a.in[2], INCOLS, 2080, 1024, D, (bf16*)(ws + WS_WIN), 2048, scr, r, lane); continue; } r -= I_B;
        if (r < I_G) { transpose_item(a.in[2], INCOLS, 2048, 32, D, (bf16*)(ws + WS_WG), 0, scr, r, lane); continue; } r -= I_G;
        if (r < I_O) { transpose_item(a.in[13], D, 0, D, D, (bf16*)(ws + WS_WOUT), 0, scr, r, lane); continue; } r -= I_O;
        if (r < I_1) { transpose_item(a.in[15], FF, 0, FF, D, (bf16*)(ws + WS_W1), 0, scr, r, lane); continue; } r -= I_1;
        transpose_item(a.in[16], D, 0, D, FF, (bf16*)(ws + WS_W2), 0, scr, r, lane);
    }
    for (int m = gw; m < M; m += NGW) rms_row_to_bf16(a.in[0] + (size_t)m * D, a.in[1], (bf16*)(ws + WS_XN) + (size_t)m * D, lane);
}

__device__ __forceinline__ void p1_gates(const Args& a, int G, int wave, int lane) {
    const bf16* XN = (const bf16*)(a.ws + WS_XN); const bf16* WG = (const bf16*)(a.ws + WS_WG); float* Gt = (float*)(a.ws + WS_G);
    const int gw = blockIdx.x * 8 + wave, NGW = G * 8;
    for (int t = gw; t < 2048; t += NGW) { const int rt = t >> 1, ct = t & 1;
        const bf16* ap = XN + (size_t)(rt * 16 + (lane & 15)) * D + (lane >> 4) * 8;
        const bf16* bp = WG + (size_t)(ct * 16 + (lane & 15)) * D + (lane >> 4) * 8;
        f32x4 acc = {0.f, 0.f, 0.f, 0.f};
#pragma unroll 8
        for (int k0 = 0; k0 < D; k0 += 32) { const bf16x8 av = *(const bf16x8*)(ap + k0), bv = *(const bf16x8*)(bp + k0); acc = MFMA16(av, bv, acc); }
#pragma unroll
        for (int j = 0; j < 4; ++j) Gt[(size_t)(rt * 16 + (lane >> 4) * 4 + j) * 32 + ct * 16 + (lane & 15)] = acc[j];
    }
}

__device__ __forceinline__ void p2_conv(const Args& a, int G, int wave, int lane, int tid) {
    const bf16* PQ = (const bf16*)(a.ws + WS_PQKV); bf16* QC = (bf16*)(a.ws + WS_QKVC); const float* cwb = a.in[3];
    const int gw = blockIdx.x * 8 + wave, NGW = G * 8;
    for (int item = gw; item < 6144; item += NGW) {
        const int slot = item >> 11, run = item & 2047, m0 = run * 8, s0 = m0 & (SEQ - 1);
        const float* cw = cwb + slot * 512 + lane * 8;
        f32x4 w[5][2];
#pragma unroll
        for (int j = 0; j < 5; ++j) { w[j][0] = *(const f32x4*)(cw + j * 1536); w[j][1] = *(const f32x4*)(cw + j * 1536 + 4); }
        v4u xr[12];
#pragma unroll
        for (int r = 0; r < 12; ++r) { const int s = s0 - 2 + r; v4u z = {0u, 0u, 0u, 0u};
            if (s >= 0 && s < SEQ) z = *(const v4u*)(PQ + (size_t)(m0 - 2 + r) * 1536 + slot * 512 + lane * 8);
            xr[r] = z; }
#pragma unroll
        for (int r = 0; r < 8; ++r) {
            float acc[8];
#pragma unroll
            for (int e = 0; e < 8; ++e) acc[e] = 0.f;
#pragma unroll
            for (int j = 0; j < 5; ++j) { const v4u xv = xr[r + j];
#pragma unroll
                for (int e = 0; e < 4; ++e) { acc[2 * e] += w[j][e >> 1][(2 * e) & 3] * bflo(xv[e]); acc[2 * e + 1] += w[j][e >> 1][(2 * e + 1) & 3] * bfhi(xv[e]); } }
            float ss = 0.f;
#pragma unroll
            for (int e = 0; e < 8; ++e) { acc[e] = silu_f(acc[e]); ss += acc[e] * acc[e]; }
            float sc = 1.f;
            if (slot < 2) { ss += __shfl_xor(ss, 1); ss += __shfl_xor(ss, 2); ss += __shfl_xor(ss, 4); sc = rsqrtf(ss + EPS); if (slot == 0) sc *= 0.125f; }
            v4u o; o.x = pk2(acc[0] * sc, acc[1] * sc); o.y = pk2(acc[2] * sc, acc[3] * sc); o.z = pk2(acc[4] * sc, acc[5] * sc); o.w = pk2(acc[6] * sc, acc[7] * sc);
            *(v4u*)(QC + (size_t)(m0 + r) * 1536 + slot * 512 + lane * 8) = o;
        }
    }
    float* Gt = (float*)(a.ws + WS_G);
    for (int e = blockIdx.x * 512 + tid; e < M * 32; e += G * 512) { const int col = e & 31, h = col & 7, kind = col >> 3; float v = Gt[e];
        if (kind < 2) v = 1.f / (1.f + __expf(-v));
        else { const float al = (kind == 2 ? a.in[4] : a.in[6])[h], db = (kind == 2 ? a.in[5] : a.in[7])[h]; const float xx = v + db;
            v = -__expf(al) * (fmaxf(xx, 0.f) + log1pf(__expf(-fabsf(xx)))); }
        Gt[e] = v; }
}

__device__ __forceinline__ void p3_passA(const Args& a, LAS unsigned char* lds, int G, int tid, int lane) {
    const bf16* QC = (const bf16*)(a.ws + WS_QKVC); const float* Gt = (const float*)(a.ws + WS_G); float* GC = (float*)(a.ws + WS_GC);
    bf16* U = (bf16*)(a.ws + WS_U); bf16* Wb = (bf16*)(a.ws + WS_WW);
    const int sub = tid >> 7, c = tid & 127, wi = (tid >> 6) & 1;
    LAS unsigned char* reg = lds + sub * 26624;
    LAS bf16* ks = (LAS bf16*)reg; LAS float* Ls = (LAS float*)(reg + 9216); LAS float* bet = (LAS float*)(reg + 9216 + 16384); LAS float* gcs = bet + 64;
    for (int base = blockIdx.x * 4; base < 4096; base += G * 4) {
        const int item = base + sub, ci = item & 31, dir = (item >> 5) & 1, h = (item >> 6) & 7, b = item >> 9;
        const int rowbase = b * SEQ + (dir ? (SEQ - 1 - ci * 64) : ci * 64), rstep = dir ? -1 : 1;
        if (c < 64) { const int r = rowbase + rstep * c; const float be = Gt[(size_t)r * 32 + dir * 8 + h]; float g = Gt[(size_t)r * 32 + 16 + dir * 8 + h];
#pragma unroll
            for (int o = 1; o < 64; o <<= 1) { const float t = __shfl_up(g, o); if (lane >= o) g += t; }
            bet[c] = be; gcs[c] = g; GC[(size_t)item * 64 + c] = g; }
#pragma unroll
        for (int it = 0; it < 4; ++it) { const int id = it * 128 + c, i = id >> 3, dc = id & 7;
            const v4u kk = *(const v4u*)(QC + (size_t)(rowbase + rstep * i) * 1536 + 512 + h * 64 + dc * 8); *(LAS v4u*)(ks + i * 72 + dc * 8) = kk; }
        __syncthreads();
#pragma unroll
        for (int mt2 = 0; mt2 < 2; ++mt2) { const int mt = wi * 2 + mt2;
            for (int nt = 0; nt <= mt; ++nt) { f32x4 acc = {0.f, 0.f, 0.f, 0.f};
#pragma unroll
                for (int k2 = 0; k2 < 2; ++k2) { const bf16x8 av = ldfrag(ks, mt * 16, k2 * 32, lane), bv = ldfrag(ks, nt * 16, k2 * 32, lane); acc = MFMA16(av, bv, acc); }
                const int j = nt * 16 + (lane & 15); const float gj = gcs[j];
#pragma unroll
                for (int jj = 0; jj < 4; ++jj) { const int i = mt * 16 + (lane >> 4) * 4 + jj; const float val = bet[i] * acc[jj] * __expf(gcs[i] - gj); Ls[i * 64 + j] = (j < i) ? val : 0.f; } } }
        __syncthreads();
        float x[64];
        if (c < 64) { const bf16* vp = QC + (size_t)rowbase * 1536 + 1024 + h * 64 + c;
#pragma unroll
            for (int i = 0; i < 64; ++i) x[i] = bet[i] * bf2f(vp[(ptrdiff_t)(rstep * i) * 1536]); }
        else { const int d = c - 64;
#pragma unroll
            for (int i = 0; i < 64; ++i) x[i] = bet[i] * __expf(gcs[i]) * bf2f(ks[i * 72 + d]); }
#pragma unroll
        for (int i = 1; i < 64; ++i) { float s0 = x[i], s1 = 0.f;
#pragma unroll
            for (int j4 = 0; j4 < i; j4 += 4) { const f32x4 l = *(const LAS f32x4*)(Ls + i * 64 + j4);
                s0 -= l[0] * x[j4];
                if (j4 + 1 < i) s1 -= l[1] * x[j4 + 1];
                if (j4 + 2 < i) s0 -= l[2] * x[j4 + 2];
                if (j4 + 3 < i) s1 -= l[3] * x[j4 + 3]; }
            x[i] = s0 + s1; }
        if (c < 64) { v4u* up = (v4u*)(U + (size_t)item * 4096 + c * 64);
#pragma unroll
            for (int q = 0; q < 8; ++q) { v4u o; o.x = pk2(x[8 * q], x[8 * q + 1]); o.y = pk2(x[8 * q + 2], x[8 * q + 3]); o.z = pk2(x[8 * q + 4], x[8 * q + 5]); o.w = pk2(x[8 * q + 6], x[8 * q + 7]); up[q] = o; } }
        else { bf16* wp = Wb + (size_t)item * 4096 + (c - 64);
#pragma unroll
            for (int i = 0; i < 64; ++i) wp[i * 64] = (bf16)f2bf(x[i]); }
        __syncthreads();
    }
}

__device__ __forceinline__ void p4_passB(const Args& a, LAS unsigned char* lds, int seq, int tid, int wave, int lane) {
    const bf16* QC = (const bf16*)(a.ws + WS_QKVC); const float* GC = (const float*)(a.ws + WS_GC);
    const bf16* U = (const bf16*)(a.ws + WS_U); const bf16* Wb = (const bf16*)(a.ws + WS_WW);
    const int b = seq >> 4, h = (seq >> 1) & 7, dir = seq & 1;
    float* od = a.out + (size_t)dir * M * 512;
    LAS bf16* Qn = (LAS bf16*)lds; LAS bf16* Kn = Qn + 4608; LAS bf16* KdT = Kn + 4608; LAS bf16* Wl = KdT + 4608; LAS bf16* Att = Wl + 4608; LAS bf16* SbT = Att + 4608; LAS bf16* VnT = SbT + 4608;
    LAS float* gcs = (LAS float*)(VnT + 4608);
    const int it = wave >> 1, et0 = (wave & 1) * 2, li = tid >> 3, dc = tid & 7, fr = lane & 15, fq = lane >> 4;
    f32x4 accS[2] = {{0.f, 0.f, 0.f, 0.f}, {0.f, 0.f, 0.f, 0.f}};
    for (int u = tid; u < 2304; u += 512) ((LAS unsigned*)SbT)[u] = 0u;
    v4u q8, k8, w8; float gci, gcl; v2u ut[2];
#define LOADCHUNK(cidx) do { const int item_ = seq * 32 + (cidx); const int s_ = (cidx) * 64 + li; const size_t r_ = (size_t)(b * SEQ + (dir ? SEQ - 1 - s_ : s_)); \
        q8 = *(const v4u*)(QC + r_ * 1536 + h * 64 + dc * 8); k8 = *(const v4u*)(QC + r_ * 1536 + 512 + h * 64 + dc * 8); \
        w8 = *(const v4u*)(Wb + (size_t)item_ * 4096 + li * 64 + dc * 8); gci = GC[(size_t)item_ * 64 + li]; gcl = GC[(size_t)item_ * 64 + 63]; \
        _Pragma("unroll") for (int e2 = 0; e2 < 2; ++e2) ut[e2] = *(const v2u*)(U + (size_t)item_ * 4096 + ((et0 + e2) * 16 + fr) * 64 + it * 16 + fq * 4); } while (0)
    LOADCHUNK(0);
    for (int ci = 0; ci < 32; ++ci) {
        { const float eg = __expf(gcl - gci);
          *(LAS v4u*)(Qn + li * 72 + dc * 8) = q8; *(LAS v4u*)(Kn + li * 72 + dc * 8) = k8; *(LAS v4u*)(Wl + li * 72 + dc * 8) = w8;
#pragma unroll
          for (int e = 0; e < 4; ++e) { KdT[(dc * 8 + 2 * e) * 72 + li] = (bf16)f2bf(bflo(k8[e]) * eg); KdT[(dc * 8 + 2 * e + 1) * 72 + li] = (bf16)f2bf(bfhi(k8[e]) * eg); }
          if (dc == 0) gcs[li] = gci; }
        const float gl = __expf(gcl);
        const v2u utc0 = ut[0], utc1 = ut[1];
        __syncthreads();
        if (ci + 1 < 32) LOADCHUNK(ci + 1);
#pragma unroll
        for (int e2 = 0; e2 < 2; ++e2) {
            const int jt = et0 + e2; f32x4 acc = {0.f, 0.f, 0.f, 0.f};
#pragma unroll
            for (int k2 = 0; k2 < 2; ++k2) { const bf16x8 av = ldfrag(Kn, jt * 16, k2 * 32, lane), bv = ldfrag(Qn, it * 16, k2 * 32, lane); acc = MFMA16(av, bv, acc); }
            const int i = it * 16 + fr, j0 = jt * 16 + fq * 4; const float gi = gcs[i]; float val[4];
#pragma unroll
            for (int jj = 0; jj < 4; ++jj) { const float t = acc[jj] * __expf(gi - gcs[j0 + jj]); val[jj] = (j0 + jj <= i) ? t : 0.f; }
            v2u o; o.x = pk2(val[0], val[1]); o.y = pk2(val[2], val[3]); *(LAS v2u*)(Att + i * 72 + j0) = o;
        }
#pragma unroll
        for (int e2 = 0; e2 < 2; ++e2) {
            const int et = et0 + e2; f32x4 acc = {0.f, 0.f, 0.f, 0.f};
#pragma unroll
            for (int k2 = 0; k2 < 2; ++k2) { const bf16x8 av = ldfrag(Wl, it * 16, k2 * 32, lane), bv = ldfrag(SbT, et * 16, k2 * 32, lane); acc = MFMA16(av, bv, acc); }
            const v2u uu = e2 ? utc1 : utc0;
            v2u o; o.x = pk2(bflo(uu.x) - acc[0], bfhi(uu.x) - acc[1]); o.y = pk2(bflo(uu.y) - acc[2], bfhi(uu.y) - acc[3]);
            *(LAS v2u*)(VnT + (et * 16 + fr) * 72 + it * 16 + fq * 4) = o;
        }
        __syncthreads();
        { const int i = it * 16 + fr; const int s = ci * 64 + i; const size_t r = (size_t)(b * SEQ + (dir ? SEQ - 1 - s : s)); const float egi = __expf(gcs[i]);
#pragma unroll
          for (int e2 = 0; e2 < 2; ++e2) {
            const int et = et0 + e2; f32x4 acc = {0.f, 0.f, 0.f, 0.f};
#pragma unroll
            for (int k2 = 0; k2 < 2; ++k2) { const bf16x8 aq = ldfrag(Qn, it * 16, k2 * 32, lane), bs = ldfrag(SbT, et * 16, k2 * 32, lane); acc = MFMA16(bs, aq, acc); }
            acc = acc * egi;
#pragma unroll
            for (int k2 = 0; k2 < 2; ++k2) { const bf16x8 aa = ldfrag(Att, it * 16, k2 * 32, lane), bv = ldfrag(VnT, et * 16, k2 * 32, lane); acc = MFMA16(bv, aa, acc); }
            *(f32x4*)(od + r * 512 + h * 64 + et * 16 + fq * 4) = acc;
          } }
#pragma unroll
        for (int e2 = 0; e2 < 2; ++e2) {
            const int et = et0 + e2; accS[e2] = accS[e2] * gl;
#pragma unroll
            for (int k2 = 0; k2 < 2; ++k2) { const bf16x8 av = ldfrag(KdT, it * 16, k2 * 32, lane), bv = ldfrag(VnT, et * 16, k2 * 32, lane); accS[e2] = MFMA16(av, bv, accS[e2]); }
        }
        __syncthreads();
#pragma unroll
        for (int e2 = 0; e2 < 2; ++e2) { v2u o; o.x = pk2(accS[e2][0], accS[e2][1]); o.y = pk2(accS[e2][2], accS[e2][3]); *(LAS v2u*)(SbT + ((et0 + e2) * 16 + fr) * 72 + it * 16 + fq * 4) = o; }
    }
#undef LOADCHUNK
    __syncthreads();
}

__device__ __forceinline__ void p4_sgu(const Args& a, LAS unsigned char* lds, int unit, int tid, int wave, int lane) {
    const bf16* PZ = (const bf16*)(a.ws + WS_PZUV); bf16* MIX = (bf16*)(a.ws + WS_MIX);
    const int g = unit & 3, n = (unit >> 2) & 15, b = unit >> 6, m0 = b * SEQ + n * 128, fr = lane & 15, fq = lane >> 4;
    LAS bf16* VT = (LAS bf16*)lds; LAS bf16* WS = VT + 128 * 136;
#pragma unroll
    for (int it = 0; it < 4; ++it) { const int id = it * 512 + tid, r = id >> 4, cc = id & 15;
        const v4u raw = *(const v4u*)(PZ + (size_t)(m0 + r) * 1536 + 1024 + g * 128 + cc * 8);
        float f[8]; float ss = 0.f;
#pragma unroll
        for (int e = 0; e < 4; ++e) { f[2 * e] = gelu_exact(bflo(raw[e])); f[2 * e + 1] = gelu_exact(bfhi(raw[e])); ss += f[2 * e] * f[2 * e] + f[2 * e + 1] * f[2 * e + 1]; }
        ss += __shfl_xor(ss, 1); ss += __shfl_xor(ss, 2); ss += __shfl_xor(ss, 4); ss += __shfl_xor(ss, 8);
        const float rs = rsqrtf(ss * (1.f / 128.f) + EPS); const float* vg = a.in[9] + g * 128 + cc * 8;
#pragma unroll
        for (int e = 0; e < 8; ++e) VT[(cc * 8 + e) * 136 + r] = (bf16)f2bf(f[e] * rs * vg[e]); }
#pragma unroll
    for (int it = 0; it < 8; ++it) { const int id = it * 512 + tid, t = id >> 5, s4 = id & 31;
        const f32x4 w = *(const f32x4*)(a.in[10] + (size_t)g * 16384 + t * 128 + s4 * 4); v2u o; o.x = pk2(w.x, w.y); o.y = pk2(w.z, w.w); *(LAS v2u*)(WS + t * 136 + s4 * 4) = o; }
    __syncthreads();
    const int t0 = wave * 16;
    f32x4 acc[8];
#pragma unroll
    for (int nt = 0; nt < 8; ++nt) acc[nt] = (f32x4){0.f, 0.f, 0.f, 0.f};
#pragma unroll
    for (int k4 = 0; k4 < 4; ++k4) { const bf16x8 av = *(const LAS bf16x8*)(WS + (t0 + fr) * 136 + k4 * 32 + fq * 8);
#pragma unroll
        for (int nt = 0; nt < 8; ++nt) { const bf16x8 bv = *(const LAS bf16x8*)(VT + (nt * 16 + fr) * 136 + k4 * 32 + fq * 8); acc[nt] = MFMA16(av, bv, acc[nt]); } }
#pragma unroll
    for (int j = 0; j < 4; ++j) { const int t = t0 + fq * 4 + j; const float bias = a.in[11][g * 128 + t];
        const bf16* up = PZ + (size_t)(m0 + t) * 1536 + 512 + g * 128 + fr; float val[8]; float ss = 0.f;
#pragma unroll
        for (int nt = 0; nt < 8; ++nt) { val[nt] = gelu_exact(bf2f(up[nt * 16])) * (acc[nt][j] + bias); ss += val[nt] * val[nt]; }
        ss += __shfl_xor(ss, 1); ss += __shfl_xor(ss, 2); ss += __shfl_xor(ss, 4); ss += __shfl_xor(ss, 8);
        const float rs = rsqrtf(ss * (1.f / 128.f) + EPS); const float* og = a.in[12] + g * 128 + fr; bf16* mp = MIX + (size_t)(m0 + t) * 1024 + 512 + g * 128 + fr;
#pragma unroll
        for (int nt = 0; nt < 8; ++nt) mp[nt * 16] = (bf16)f2bf(val[nt] * rs * og[nt * 16]); }
    __syncthreads();
}

__device__ __forceinline__ void p5_gnorm(const Args& a, int G, int wave, int lane) {
    const bf16* PZ = (const bf16*)(a.ws + WS_PZUV); bf16* MIX = (bf16*)(a.ws + WS_MIX);
    const int gw = blockIdx.x * 8 + wave, NGW = G * 8;
    const f32x4 g0 = *(const f32x4*)(a.in[8] + (lane & 7) * 8), g1 = *(const f32x4*)(a.in[8] + (lane & 7) * 8 + 4);
    for (int m = gw; m < M; m += NGW) {
        const float* of = a.out + (size_t)m * 512 + lane * 8; const float* ob = of + (size_t)M * 512;
        const f32x4 o0 = *(const f32x4*)of + *(const f32x4*)ob, o1 = *(const f32x4*)(of + 4) + *(const f32x4*)(ob + 4);
        float ss = (o0.x * o0.x + o0.y * o0.y) + (o0.z * o0.z + o0.w * o0.w) + (o1.x * o1.x + o1.y * o1.y) + (o1.z * o1.z + o1.w * o1.w);
        ss += __shfl_xor(ss, 1); ss += __shfl_xor(ss, 2); ss += __shfl_xor(ss, 4);
        const float rs = rsqrtf(ss * (1.f / 64.f) + EPS);
        const v4u zz = *(const v4u*)(PZ + (size_t)m * 1536 + lane * 8);
        v4u o;
        o.x = pk2(o0.x * rs * g0.x * silu_f(bflo(zz.x)), o0.y * rs * g0.y * silu_f(bfhi(zz.x)));
        o.y = pk2(o0.z * rs * g0.z * silu_f(bflo(zz.y)), o0.w * rs * g0.w * silu_f(bfhi(zz.y)));
        o.z = pk2(o1.x * rs * g1.x * silu_f(bflo(zz.z)), o1.y * rs * g1.y * silu_f(bfhi(zz.z)));
        o.w = pk2(o1.z * rs * g1.z * silu_f(bflo(zz.w)), o1.w * rs * g1.w * silu_f(bfhi(zz.w)));
        *(v4u*)(MIX + (size_t)m * 1024 + lane * 8) = o;
    }
}

__global__ void __launch_bounds__(512, 2) fwd_mega(Args a) {
    extern __shared__ __attribute__((aligned(16))) unsigned char lds_raw[];
    LAS unsigned char* lds = (LAS unsigned char*)lds_raw;
    cg::grid_group grid = cg::this_grid();
#define GSYNC() xcd_barrier(xbar)
    const int tid = threadIdx.x, lane = tid & 63, wave = __builtin_amdgcn_readfirstlane(tid >> 6), G = gridDim.x, bid = blockIdx.x;
    unsigned char* ws = a.ws;
    const int gw = bid * 8 + wave, NGW = G * 8;
    if (a.ph_lo < 0) grid.sync();
    volatile LAS unsigned* misc = (volatile LAS unsigned*)(lds + 131072 + 64);
    if (tid < 16) misc[tid] = 0u;
    __syncthreads();
    XcdBarrier xbar = xcd_barrier_post((unsigned*)ws + 4096, misc);

#define IN(k) (a.ph_lo <= (k) && (k) < a.ph_hi)
#ifndef MK_SYNCREP
#define MK_SYNCREP 1
#endif
#define SEAM(k) do { if (IN(k) && IN((k) + 1)) for (int r_ = 0; r_ < MK_SYNCREP; ++r_) GSYNC(); } while (0)
    if (IN(0)) p0_prep(a, lds, G, wave, lane);
    SEAM(0);
    if (IN(1)) {
        pg8::Gemm g{(const pg8::bf16_t*)(ws + WS_XN), (const pg8::bf16_t*)(ws + WS_WIN), M, NIN, D}; pg8::StaticOrder S; S.init(M, NIN, G, bid);
        pg8::EpiBf16<0> E{(pg8::bf16_t*)(ws + WS_PQKV), 1536, 1536, (size_t)(WS_PZUV - WS_PQKV) / 2};
        pg8::gemm_phase<pg8::EpiBf16<0>, pg8::StaticOrder, true, true>(lds, g, S, E);
        p1_gates(a, G, wave, lane);
    }
    SEAM(1);
    if (IN(2)) p2_conv(a, G, wave, lane, tid);
    SEAM(2);
    if (IN(3)) for (int rep = 0; rep < MK_REP3; ++rep) p3_passA(a, lds, G, tid, lane);
    SEAM(3);
    if (IN(4)) for (int rep = 0; rep < MK_REP4; ++rep) {
        if (G >= 256) { if (bid < 128) p4_passB(a, lds, bid, tid, wave, lane); else for (int u = bid - 128; u < 512; u += G - 128) p4_sgu(a, lds, u, tid, wave, lane); }
        else { for (int s = bid; s < 128; s += G) p4_passB(a, lds, s, tid, wave, lane); for (int u = bid; u < 512; u += G) p4_sgu(a, lds, u, tid, wave, lane); }
    }
    SEAM(4);
    if (IN(5)) p5_gnorm(a, G, wave, lane);
    SEAM(5);
    if (IN(6)) {
        pg8::Gemm g{(const pg8::bf16_t*)(ws + WS_MIX), (const pg8::bf16_t*)(ws + WS_WOUT), M, D, D}; pg8::StaticOrder S; S.init(M, D, G, bid);
        pg8::EpiResF32 E{a.in[0], a.out, D};
        pg8::gemm_phase<pg8::EpiResF32, pg8::StaticOrder, true, true>(lds, g, S, E);
    }
    SEAM(6);
    if (IN(7)) for (int m = gw; m < M; m += NGW) rms_row_to_bf16(a.out + (size_t)m * D, a.in[14], (bf16*)(ws + WS_XN) + (size_t)m * D, lane);
    SEAM(7);
    if (IN(8)) {
        pg8::Gemm g{(const pg8::bf16_t*)(ws + WS_XN), (const pg8::bf16_t*)(ws + WS_W1), M, FF, D}; pg8::StaticOrder S; S.init(M, FF, G, bid);
        pg8::EpiBf16<2> E{(pg8::bf16_t*)(ws + WS_H), FF, 0, 0};
        pg8::gemm_phase<pg8::EpiBf16<2>, pg8::StaticOrder, true, true>(lds, g, S, E);
    }
    SEAM(8);
    if (IN(9)) {
        pg8::Gemm g{(const pg8::bf16_t*)(ws + WS_H), (const pg8::bf16_t*)(ws + WS_W2), M, D, FF}; pg8::StaticOrder S; S.init(M, D, G, bid);
        pg8::EpiResF32 E{a.out, a.out, D};
        pg8::gemm_phase<pg8::EpiResF32, pg8::StaticOrder, true, true>(lds, g, S, E);
    }
    SEAM(9);
    if (IN(10)) for (int m = gw; m < M; m += NGW) rms_row_f32_inplace(a.out + (size_t)m * D, a.in[17], lane);
    if (a.ph_lo == 21) {
        const bf16* QC = (const bf16*)(ws + WS_QKVC); const float* Gt = (const float*)(ws + WS_G);
        for (size_t e = (size_t)bid * 512 + tid; e < (size_t)M * D; e += (size_t)G * 512) { const size_t m = e >> 10; const int c = (int)(e & 1023);
            a.out[e] = bf2f(QC[m * 1536 + c]) + (c < 512 ? bf2f(QC[m * 1536 + 1024 + c]) : Gt[m * 32 + (c & 31)]); } }
    if (a.ph_lo == 22) {
        const bf16* U = (const bf16*)(ws + WS_U); const bf16* Wb = (const bf16*)(ws + WS_WW); const float* GC = (const float*)(ws + WS_GC);
        for (size_t e = (size_t)bid * 512 + tid; e < (size_t)M * D; e += (size_t)G * 512) a.out[e] = bf2f(U[e]) + bf2f(Wb[e]) + GC[e & 262143]; }
    if (a.ph_lo == 20) {
        const bf16* PQ = (const bf16*)(ws + WS_PQKV); const bf16* PZ = (const bf16*)(ws + WS_PZUV); const float* Gt = (const float*)(ws + WS_G);
        for (size_t e = (size_t)bid * 512 + tid; e < (size_t)M * D; e += (size_t)G * 512) { const size_t m = e >> 10; const int c = (int)(e & 1023);
            a.out[e] = bf2f(PQ[m * 1536 + c]) + bf2f(PZ[m * 1536 + c]) + (c < 512 ? bf2f(PQ[m * 1536 + 1024 + c]) + bf2f(PZ[m * 1536 + 1024 + c]) : Gt[m * 32 + (c & 31)]); } }
}

extern "C" void kernel_launch(void* const* d_in, const int* in_sizes, int n_in, void* d_out, int out_size, void* d_ws, size_t ws_size, hipStream_t stream) {
    static int grid_blocks = 0;
    if (grid_blocks == 0) {
        int dev = 0, cus = 0, per_cu = 0;
        (void)hipGetDevice(&dev);
        (void)hipDeviceGetAttribute(&cus, hipDeviceAttributeMultiprocessorCount, dev);
        if (hipFuncSetAttribute((const void*)fwd_mega, hipFuncAttributeMaxDynamicSharedMemorySize, LDS_BYTES) != hipSuccess) fprintf(stderr, "hipFuncSetAttribute failed\n");
        if (hipOccupancyMaxActiveBlocksPerMultiprocessor(&per_cu, (const void*)fwd_mega, 512, LDS_BYTES) != hipSuccess || per_cu < 1) { fprintf(stderr, "occupancy query: %d\n", per_cu); per_cu = 1; }
        (void)hipGetLastError();
        grid_blocks = cus * per_cu;
        if (n_in != 18 || ws_size < 256 * MiB) fprintf(stderr, "kernel_launch: unexpected n_in %d / ws %zu\n", n_in, ws_size);
    }
    Args a{};
    for (int i = 0; i < 18; ++i) a.in[i] = (const float*)d_in[i];
    a.out = (float*)d_out; a.ws = (unsigned char*)d_ws;
    void* args[] = {&a};
    (void)hipMemsetAsync(d_ws, 0, 1 * MiB, stream);
#if MK_DIAG_MEMSET
    (void)hipMemsetAsync(d_ws, 0, 256 * MiB, stream); (void)hipMemsetAsync(d_out, 0, (size_t)M * D * 4, stream);
#endif
#if MK_MULTI
    for (int p = 0; p < MK_LAST; ++p) { a.ph_lo = p; a.ph_hi = p + 1;
        hipError_t e = hipLaunchCooperativeKernel((const void*)fwd_mega, dim3(grid_blocks), dim3(512), args, LDS_BYTES, stream);
        if (e != hipSuccess) fprintf(stderr, "launch %d failed: %s (grid %d)\n", p, hipGetErrorString(e), grid_blocks); }
#ifdef MK_DUMP
    a.ph_lo = MK_DUMP; a.ph_hi = MK_DUMP; (void)hipLaunchCooperativeKernel((const void*)fwd_mega, dim3(grid_blocks), dim3(512), args, LDS_BYTES, stream);
#endif
#else
    a.ph_lo = 0; a.ph_hi = 11;
    hipError_t e = hipLaunchCooperativeKernel((const void*)fwd_mega, dim3(grid_blocks), dim3(512), args, LDS_BYTES, stream);
    if (e != hipSuccess) fprintf(stderr, "cooperative launch failed: %s (grid %d)\n", hipGetErrorString(e), grid_blocks);
#endif
}
```
